# Optimizing an MI355X kernel written in HIP

```python
import math
import jax, jax.numpy as jnp
from jax import lax
import numpy as np

D_MODEL = 1024
BATCH = 32
SEQ = 2048
DEPTH = 1

SSM_GROUP = 16
SSM_WIDTH = D_MODEL // 2
SSM_GROUPS = SSM_WIDTH // SSM_GROUP
SSM_STATE = 64
CONV_WIDTH = D_MODEL
CONV_K = 3
D_FF = 4 * D_MODEL
NORM_EPS = 1e-6
DT_MIN = 1e-3
DT_MAX = 1e-1
SPLIT_SIZES = (SSM_WIDTH, CONV_WIDTH, CONV_WIDTH, CONV_WIDTH, D_MODEL, D_MODEL)
IN_COLS = sum(SPLIT_SIZES)
SPLIT_POINTS = tuple(int(v) for v in np.cumsum(SPLIT_SIZES)[:-1])

kernel_name = "hybrid_s5_shortconv_gated_block"


def rmsnorm(x, g):
    xf = x.astype(jnp.float32)
    var = jnp.mean(xf * xf, axis=-1, keepdims=True)
    return (xf * lax.rsqrt(var + NORM_EPS) * g.astype(jnp.float32)).astype(x.dtype)


def _ssm_combine(e1, e2):
    a1r, a1i, b1r, b1i = e1
    a2r, a2i, b2r, b2i = e2
    ar = a1r * a2r - a1i * a2i
    ai = a1r * a2i + a1i * a2r
    br = a2r * b1r - a2i * b1i + b2r
    bi = a2r * b1i + a2i * b1r + b2i
    return (ar, ai, br, bi)


def s5_branch(u, lam_re, lam_im, log_dt, b_re, b_im, c_re, c_im, d_skip):
    f32 = jnp.float32
    bsz, seq, _ = u.shape
    uf = u.astype(f32).reshape(bsz, seq, SSM_GROUPS, SSM_GROUP)
    lr = lam_re.astype(f32)
    li = lam_im.astype(f32)
    dt = jnp.exp(log_dt.astype(f32))[:, None]
    mag = jnp.exp(lr * dt)
    ab_re = mag * jnp.cos(li * dt)
    ab_im = mag * jnp.sin(li * dt)
    er = ab_re - 1.0
    ei = ab_im
    den = lr * lr + li * li
    q_re = (er * lr + ei * li) / den
    q_im = (ei * lr - er * li) / den
    br = b_re.astype(f32)
    bi = b_im.astype(f32)
    bb_re = q_re[..., None] * br - q_im[..., None] * bi
    bb_im = q_re[..., None] * bi + q_im[..., None] * br
    bu_re = jnp.einsum('gnc,bsgc->bsgn', bb_re, uf)
    bu_im = jnp.einsum('gnc,bsgc->bsgn', bb_im, uf)
    a_re = jnp.broadcast_to(ab_re[None, None], (1, seq, SSM_GROUPS, SSM_STATE))
    a_im = jnp.broadcast_to(ab_im[None, None], (1, seq, SSM_GROUPS, SSM_STATE))
    _, _, s_re, s_im = lax.associative_scan(_ssm_combine, (a_re, a_im, bu_re, bu_im), axis=1)
    y = (jnp.einsum('gcn,bsgn->bsgc', c_re.astype(f32), s_re)
         - jnp.einsum('gcn,bsgn->bsgc', c_im.astype(f32), s_im))
    y = y + d_skip.astype(f32).reshape(SSM_GROUPS, SSM_GROUP) * uf
    return y.reshape(bsz, seq, SSM_WIDTH)


def causal_short_conv(v, w, b):
    seq = v.shape[1]
    vp = jnp.pad(v, ((0, 0), (CONV_K - 1, 0), (0, 0)))
    out = b
    for k in range(CONV_K):
        out = out + w[k] * vp[:, k:k + seq]
    return out


def mixer_block(xn, w_in, b_in, lam_re, lam_im, log_dt, b_re, b_im, c_re, c_im, d_skip,
                w_glu_a, w_glu_b, conv_w, conv_b, w_conv_out, w_out):
    proj = jnp.einsum('bsd,de->bse', xn, w_in) + b_in
    u_ssm, c_bgate, c_cgate, c_val, g_ssm, g_conv = jnp.split(proj, SPLIT_POINTS, axis=-1)
    y_ssm = s5_branch(u_ssm, lam_re, lam_im, log_dt, b_re, b_im, c_re, c_im, d_skip).astype(xn.dtype)
    z = jax.nn.gelu(y_ssm)
    y_a = jnp.einsum('bse,ed->bsd', z, w_glu_a) * jax.nn.sigmoid(jnp.einsum('bse,ed->bsd', z, w_glu_b))
    y_b = jnp.einsum('bse,ed->bsd', c_bgate * causal_short_conv(c_cgate * c_val, conv_w, conv_b), w_conv_out)
    merged = jax.nn.sigmoid(g_ssm) * y_a + jax.nn.sigmoid(g_conv) * y_b
    return jnp.einsum('bsd,de->bse', merged, w_out)


def squared_relu_mlp(xn, w_ff1, w_ff2):
    h = jax.nn.relu(jnp.einsum('bsd,df->bsf', xn, w_ff1))
    return jnp.einsum('bsf,fd->bsd', h * h, w_ff2)


def setup_inputs(seed: int = 0) -> dict:
    key = jax.random.key(seed)
    ks = jax.random.split(key, 24)
    L, D, G, N, C = DEPTH, D_MODEL, SSM_GROUPS, SSM_STATE, SSM_GROUP
    nrm = jax.random.normal
    x = nrm(ks[0], (BATCH, SEQ, D), jnp.float32)
    norm_mix_g = 1.0 + 0.02 * nrm(ks[1], (L, D), jnp.float32)
    w_in = nrm(ks[2], (L, D, IN_COLS), jnp.float32) * D ** -0.5
    b_in = 0.02 * nrm(ks[3], (L, IN_COLS), jnp.float32)
    n_idx = jnp.arange(N, dtype=jnp.float32)
    lam_re = -0.5 + 0.01 * nrm(ks[4], (L, G, N), jnp.float32)
    lam_im = math.pi * n_idx[None, None, :] + 0.01 * nrm(ks[5], (L, G, N), jnp.float32)
    log_dt = jax.random.uniform(ks[6], (L, G), jnp.float32, math.log(DT_MIN), math.log(DT_MAX))
    ssm_b_re = nrm(ks[7], (L, G, N, C), jnp.float32) * (2.0 * C) ** -0.5
    ssm_b_im = nrm(ks[8], (L, G, N, C), jnp.float32) * (2.0 * C) ** -0.5
    ssm_c_re = nrm(ks[9], (L, G, C, N), jnp.float32) * (2.0 * N) ** -0.5
    ssm_c_im = nrm(ks[10], (L, G, C, N), jnp.float32) * (2.0 * N) ** -0.5
    ssm_d = 1.0 + 0.1 * nrm(ks[11], (L, SSM_WIDTH), jnp.float32)
    w_glu_a = nrm(ks[12], (L, SSM_WIDTH, D), jnp.float32) * SSM_WIDTH ** -0.5
    w_glu_b = nrm(ks[13], (L, SSM_WIDTH, D), jnp.float32) * SSM_WIDTH ** -0.5
    conv_w = nrm(ks[14], (L, CONV_K, CONV_WIDTH), jnp.float32) * CONV_K ** -0.5
    conv_b = 0.02 * nrm(ks[15], (L, CONV_WIDTH), jnp.float32)
    w_conv_out = nrm(ks[16], (L, CONV_WIDTH, D), jnp.float32) * CONV_WIDTH ** -0.5
    w_out = nrm(ks[17], (L, D, D), jnp.float32) * D ** -0.5
    norm_mlp_g = 1.0 + 0.02 * nrm(ks[18], (L, D), jnp.float32)
    w_ff1 = nrm(ks[19], (L, D, D_FF), jnp.float32) * D ** -0.5
    w_ff2 = nrm(ks[20], (L, D_FF, D), jnp.float32) * D_FF ** -0.5
    norm_final_g = 1.0 + 0.02 * nrm(ks[21], (D,), jnp.float32)
    return {"x": x, "norm_mix_g": norm_mix_g, "w_in": w_in, "b_in": b_in,
            "lam_re": lam_re, "lam_im": lam_im, "log_dt": log_dt,
            "ssm_b_re": ssm_b_re, "ssm_b_im": ssm_b_im, "ssm_c_re": ssm_c_re, "ssm_c_im": ssm_c_im,
            "ssm_d": ssm_d, "w_glu_a": w_glu_a, "w_glu_b": w_glu_b,
            "conv_w": conv_w, "conv_b": conv_b, "w_conv_out": w_conv_out, "w_out": w_out,
            "norm_mlp_g": norm_mlp_g, "w_ff1": w_ff1, "w_ff2": w_ff2, "norm_final_g": norm_final_g}


def reference(x, norm_mix_g, w_in, b_in, lam_re, lam_im, log_dt, ssm_b_re, ssm_b_im, ssm_c_re, ssm_c_im,
              ssm_d, w_glu_a, w_glu_b, conv_w, conv_b, w_conv_out, w_out, norm_mlp_g, w_ff1, w_ff2,
              norm_final_g):
    h = x
    for l in range(DEPTH):
        xn = rmsnorm(h, norm_mix_g[l])
        h = h + mixer_block(xn, w_in[l], b_in[l], lam_re[l], lam_im[l], log_dt[l],
                            ssm_b_re[l], ssm_b_im[l], ssm_c_re[l], ssm_c_im[l], ssm_d[l],
                            w_glu_a[l], w_glu_b[l], conv_w[l], conv_b[l], w_conv_out[l], w_out[l])
        xn = rmsnorm(h, norm_mlp_g[l])
        h = h + squared_relu_mlp(xn, w_ff1[l], w_ff2[l])
    return rmsnorm(h, norm_final_g)
```

```cpp
#include <hip/hip_runtime.h>
#include <cstdio>
#include <cstdint>

#ifndef MK_PER_PHASE
#define MK_PER_PHASE 0
#endif

namespace pg8 {
#define PG8_LAS __attribute__((address_space(3)))
typedef unsigned short bf16_t;
typedef short bf16x8 __attribute__((ext_vector_type(8)));
typedef float f32x4 __attribute__((ext_vector_type(4)));
typedef unsigned u32x4 __attribute__((ext_vector_type(4)));
typedef unsigned u32x2 __attribute__((ext_vector_type(2)));
constexpr int BM = 256, BK = 64, HALF = 128, HTB = HALF * BK * 2  , STAGE_BYTES = 8 * HTB, NXCD = 8, WGM = 8;

__host__ __device__ __forceinline__ int lds_byte(int r, int c) { const int st = (r >> 4) * 2 + (c >> 5), rr = r & 15, cc = c & 31, ob = rr * 64 + cc * 2; return st * 1024 + (ob ^ (((ob >> 9) & 1) << 5)); }
__host__ __device__ __forceinline__ void stage_rc(int b, int& R, int& C) { const int st = b / 1024, sb = b % 1024, swz = sb ^ (((sb >> 9) & 1) << 5); R = (st >> 1) * 16 + swz / 64; C = (st & 1) * 32 + (swz % 64) / 2; }
__host__ __device__ __forceinline__ int perm32(int rho) { const int n = rho >> 4, i = rho & 15; return 8 * (i >> 2) + 4 * n + (i & 3); }

struct Unit { int pm, pn, kind; };
struct Gemm { const unsigned char* ws; unsigned Aoff, Boff; int lda, ldb, K; };
#define PG8_RSRC(base) __builtin_amdgcn_make_buffer_rsrc((void*)(base), 0, 0x7fffffff, 0x00020000)

struct StaticOrder {
    int nM, nN, nwg, G, c;
    __device__ void init(int M, int N, int G_, int c_) { nM = M / BM; nN = N / BM; nwg = nM * nN; G = G_; c = c_; }
    __device__ bool next(int i, Unit& u) const {
        const long L = (long)i * G + c; if (L >= nwg) return false;
        int wgid = (int)L; { const int q = nwg / NXCD, r = nwg % NXCD, xcd = wgid % NXCD, off = wgid / NXCD; wgid = (xcd < r ? xcd * (q + 1) : r * (q + 1) + (xcd - r) * q) + off; }
        const int nig = WGM * nN, gid = wgid / nig, fm = gid * WGM, gsz = (nM - fm) < WGM ? (nM - fm) : WGM;
        u.pm = fm + ((wgid % nig) % gsz); u.pn = (wgid % nig) / gsz; u.kind = 0; return true;
    }
    __device__ __forceinline__ size_t arow(const Unit& u) const { return (size_t)u.pm * BM; }
    __device__ __forceinline__ size_t brow(const Unit& u) const { return (size_t)u.pn * BM; }
};
struct GroupOrder {
    int nunits, G, c, brows;
    __device__ bool next(int i, Unit& u) const { const int L = i * G + c; if (L >= nunits) return false; u.pm = L; u.pn = 0; u.kind = 0; return true; }
    __device__ __forceinline__ size_t arow(const Unit& u) const { return (size_t)u.pm * BM; }
    __device__ __forceinline__ size_t brow(const Unit& u) const { return (size_t)(u.pm >> 4) * brows; }
};

__device__ __forceinline__ unsigned cvt_pk_bf16(float lo, float hi) { unsigned r; asm volatile("v_cvt_pk_bf16_f32 %0, %1, %2" : "=v"(r) : "v"(lo), "v"(hi)); return r; }
__device__ __forceinline__ float bf_lo(unsigned w) { return __uint_as_float(w << 16); }
__device__ __forceinline__ float bf_hi(unsigned w) { return __uint_as_float(w & 0xffff0000u); }
__device__ __forceinline__ float relu_f(float x) { float r; asm("v_max_f32 %0, 0, %1" : "=v"(r) : "v"(x)); return r; }
__device__ __forceinline__ float sigmoid_f(float x) { return __builtin_amdgcn_rcpf(1.0f + __builtin_amdgcn_exp2f(-1.4426950409f * x)); }
__device__ __forceinline__ float gelu_tanh_f(float x) { const float z = x * (1.0f + 0.044715f * x * x); return x * __builtin_amdgcn_rcpf(1.0f + __builtin_amdgcn_exp2f(-2.3022081981f * z)); }
__device__ __forceinline__ u32x4 pack8(const f32x4& a, const f32x4& b) { u32x4 w; w.x = cvt_pk_bf16(a[0], a[1]); w.y = cvt_pk_bf16(a[2], a[3]); w.z = cvt_pk_bf16(b[0], b[1]); w.w = cvt_pk_bf16(b[2], b[3]); return w; }
__device__ __forceinline__ void unpack8(const u32x4& w, f32x4& a, f32x4& b) { a = (f32x4){bf_lo(w.x), bf_hi(w.x), bf_lo(w.y), bf_hi(w.y)}; b = (f32x4){bf_lo(w.z), bf_hi(w.z), bf_lo(w.w), bf_hi(w.w)}; }

template <class Epi, class Sched>
__device__ __forceinline__ void gemm_phase(PG8_LAS unsigned char* lds, const Gemm g, const Sched& S, const Epi& E) {
    const int tid = threadIdx.x, wid = __builtin_amdgcn_readfirstlane(tid >> 6), lane = tid & 63, wr = wid >> 2, wc = wid & 3, fr = lane & 15, fq = lane >> 4;
    const int nt = g.K / BK;
    unsigned voffA[2], voffB[2];
#pragma unroll
    for (int i = 0; i < 2; ++i) { int R, C; stage_rc(tid * 16 + i * 8192, R, C); const int Rb = Epi::PERM ? ((R & ~31) + perm32(R & 31)) : R;
        const int Ra = Epi::ROWPERM ? (128 * (R >> 6) + 8 * (R & 15) + ((R >> 4) & 3)) : R;
        voffA[i] = (unsigned)(Ra * g.lda + C) * 2u; voffB[i] = (unsigned)(Rb * g.ldb + C) * 2u; }
    const __amdgpu_buffer_rsrc_t rs = PG8_RSRC(g.ws);
    const unsigned kstep = (unsigned)(BK * 2);
    const unsigned hstepA = (unsigned)(Epi::ROWPERM ? 4 : HALF) * g.lda * 2, hstepB = (unsigned)HALF * g.ldb * 2;
    const unsigned ldsw = (unsigned)wid * 1024u;
    const int aoff = lds_byte(wr * 64 + fr, fq * 8), boff = lds_byte(wc * 32 + fr, fq * 8);
#define PG8_SA(b, h) (((b) * 2 + (h)) * HTB)
#define PG8_SB(b, h) ((4 + (b) * 2 + (h)) * HTB)
#define PG8_STAGE(bufoff, soff, voff) do { _Pragma("unroll") for (int _i = 0; _i < 2; ++_i) \
        __builtin_amdgcn_raw_ptr_buffer_load_lds(rs, (PG8_LAS void*)(lds + (bufoff) + ldsw + _i * 8192), 16, (voff)[_i], (soff), 0, 0); } while (0)
#define PG8_LDA(dst, b, h) do { _Pragma("unroll") for (int m = 0; m < 4; ++m) _Pragma("unroll") for (int k = 0; k < 2; ++k) dst[m][k] = *(const PG8_LAS bf16x8*)(lds + PG8_SA(b, h) + aoff + m * 2048 + k * 1024); } while (0)
#define PG8_LDB(dst, b, h) do { _Pragma("unroll") for (int n = 0; n < 2; ++n) _Pragma("unroll") for (int k = 0; k < 2; ++k) dst[n][k] = *(const PG8_LAS bf16x8*)(lds + PG8_SB(b, h) + boff + n * 2048 + k * 1024); } while (0)
#define PG8_MMA(ai, bj, At, Bt) do { __builtin_amdgcn_s_setprio(1); _Pragma("unroll") for (int m = 0; m < 4; ++m) _Pragma("unroll") for (int n = 0; n < 2; ++n) _Pragma("unroll") for (int k = 0; k < 2; ++k) \
        acc[ai][bj][m][n] = __builtin_amdgcn_mfma_f32_16x16x32_bf16(Bt[n][k], At[m][k], acc[ai][bj][m][n], 0, 0, 0); __builtin_amdgcn_s_setprio(0); } while (0)
#define PG8_WAIT_V(n) asm volatile("s_waitcnt vmcnt(" #n ")" ::: "memory")
#define PG8_WAIT_VR() asm volatile("s_waitcnt vmcnt(%0)" :: "i"(8 + Epi::NST) : "memory")
#define PG8_WAIT_L(n) asm volatile("s_waitcnt lgkmcnt(" #n ")" ::: "memory")
#define PG8_BAR __builtin_amdgcn_s_barrier()
#define PG8_SCHED __builtin_amdgcn_sched_barrier(0)
    Unit cur, nxt; int ui = 0;
    if (!S.next(0, cur)) return;
    f32x4 acc[2][2][4][2];
#pragma unroll
    for (int a = 0; a < 2; ++a)
#pragma unroll
        for (int b = 0; b < 2; ++b)
#pragma unroll
            for (int m = 0; m < 4; ++m)
#pragma unroll
                for (int n = 0; n < 2; ++n) acc[a][b][m][n] = (f32x4){0.f, 0.f, 0.f, 0.f};
    bf16x8 At[4][2], B0[2][2], B1[2][2];
    unsigned cA = g.Aoff + (unsigned)(S.arow(cur) * (size_t)g.lda * 2), cB = g.Boff + (unsigned)(S.brow(cur) * (size_t)g.ldb * 2);
    PG8_STAGE(PG8_SB(0, 0), cB, voffB); PG8_STAGE(PG8_SB(0, 1), cB + hstepB, voffB); PG8_STAGE(PG8_SA(0, 0), cA, voffA); PG8_STAGE(PG8_SA(0, 1), cA + hstepA, voffA);
    if (wr == 1) PG8_BAR;
    PG8_WAIT_V(2); PG8_BAR;
    PG8_STAGE(PG8_SB(1, 0), cB + kstep, voffB); PG8_STAGE(PG8_SA(1, 0), cA + kstep, voffA); PG8_STAGE(PG8_SB(1, 1), cB + hstepB + kstep, voffB);
    PG8_WAIT_V(6); PG8_BAR;
    for (;;) {
        const bool has_next = S.next(ui + 1, nxt);
        const unsigned nA = has_next ? g.Aoff + (unsigned)(S.arow(nxt) * (size_t)g.lda * 2) : cA, nB = has_next ? g.Boff + (unsigned)(S.brow(nxt) * (size_t)g.ldb * 2) : cB;
#pragma unroll 1
        for (int t = 0; t < nt; t += 2) {
            const bool last = (t == nt - 2);
            const bool relax = (t == 0) && (ui > 0);
            const unsigned a1 = cA + (unsigned)(t + 1) * kstep;
            const unsigned a2 = last ? nA : cA + (unsigned)(t + 2) * kstep, b2 = last ? nB : cB + (unsigned)(t + 2) * kstep;
            const unsigned a3 = a2 + kstep, b3 = b2 + kstep;
            PG8_LDB(B0, 0, 0); PG8_LDB(B1, 0, 1); PG8_SCHED; PG8_LDA(At, 0, 0); PG8_STAGE(PG8_SA(1, 1), a1 + hstepA, voffA);
            if (relax) PG8_WAIT_VR(); else PG8_WAIT_V(8);
            PG8_WAIT_L(0); PG8_BAR; PG8_MMA(0, 0, At, B0); PG8_MMA(0, 1, At, B1); PG8_BAR; PG8_SCHED;
            PG8_LDA(At, 0, 1); PG8_STAGE(PG8_SB(0, 0), b2, voffB); PG8_STAGE(PG8_SB(0, 1), b2 + hstepB, voffB); PG8_STAGE(PG8_SA(0, 0), a2, voffA);
            if (relax) PG8_WAIT_VR(); else PG8_WAIT_V(8);
            PG8_WAIT_L(0); PG8_BAR; PG8_MMA(1, 0, At, B0); PG8_MMA(1, 1, At, B1); PG8_BAR; PG8_SCHED;
            PG8_LDB(B0, 1, 0); PG8_LDB(B1, 1, 1); PG8_SCHED; PG8_LDA(At, 1, 0); PG8_STAGE(PG8_SA(0, 1), a2 + hstepA, voffA);
            PG8_WAIT_V(8); PG8_WAIT_L(0); PG8_BAR; PG8_MMA(0, 0, At, B0); PG8_MMA(0, 1, At, B1); PG8_BAR; PG8_SCHED;
            PG8_LDA(At, 1, 1); PG8_STAGE(PG8_SB(1, 0), b3, voffB); PG8_STAGE(PG8_SB(1, 1), b3 + hstepB, voffB); PG8_STAGE(PG8_SA(1, 0), a3, voffA);
            PG8_WAIT_V(8); PG8_WAIT_L(0); PG8_BAR; PG8_MMA(1, 0, At, B0); PG8_MMA(1, 1, At, B1); PG8_BAR; PG8_SCHED;
        }
        if (wr == 0) PG8_BAR;
        E(acc, cur, ui, wr, wc, fr, fq);
        if (!has_next) break;
#pragma unroll
        for (int a = 0; a < 2; ++a)
#pragma unroll
            for (int b = 0; b < 2; ++b)
#pragma unroll
                for (int m = 0; m < 4; ++m)
#pragma unroll
                    for (int n = 0; n < 2; ++n) acc[a][b][m][n] = (f32x4){0.f, 0.f, 0.f, 0.f};
        cur = nxt; cA = nA; cB = nB; ++ui;
        if (wr == 1) PG8_BAR;
    }
    PG8_WAIT_V(0);
    PG8_BAR;
#undef PG8_SA
#undef PG8_SB
#undef PG8_STAGE
#undef PG8_LDA
#undef PG8_LDB
#undef PG8_MMA
#undef PG8_WAIT_V
#undef PG8_WAIT_VR
#undef PG8_WAIT_L
#undef PG8_BAR
#undef PG8_SCHED
}

struct G2Order {
    StaticOrder base;
    __device__ bool next(int i, Unit& u) const { const int tg = i / 3, sub = i - 3 * tg; Unit b; if (!base.next(tg, b)) return false;
        u.pm = b.pm; u.kind = sub ? 1 : 0; u.pn = sub ? 2 * b.pn + sub - 1 : b.pn; return true; }
};
template <class Epi, class Sched>
__device__ __forceinline__ void gemm_phase_multi(PG8_LAS unsigned char* lds, const unsigned char* ws, unsigned gA0, unsigned gB0, unsigned gA1, unsigned gB1, const Sched& S, const Epi& E) {
    const int tid = threadIdx.x, wid = __builtin_amdgcn_readfirstlane(tid >> 6), lane = tid & 63, wr = wid >> 2, wc = wid & 3, fr = lane & 15, fq = lane >> 4;
    unsigned vA[2], vB[2], rA[2], rB[2];
#pragma unroll
    for (int i = 0; i < 2; ++i) { int R, C; stage_rc(tid * 16 + i * 8192, R, C); const int Rb = Epi::PERM ? ((R & ~31) + perm32(R & 31)) : R;
        vA[i] = (unsigned)(R * 1024 + C) * 2u; rA[i] = (unsigned)R * 1024u; vB[i] = (unsigned)(Rb * 1024 + C) * 2u; rB[i] = (unsigned)Rb * 1024u; }
    const __amdgpu_buffer_rsrc_t rs = PG8_RSRC(ws);
    const unsigned kstep = (unsigned)(BK * 2);
    const unsigned ldsw = (unsigned)wid * 1024u;
    const int aoff = lds_byte(wr * 64 + fr, fq * 8), boff = lds_byte(wc * 32 + fr, fq * 8);
#define PG8_SA(b, h) (((b) * 2 + (h)) * HTB)
#define PG8_SB(b, h) ((4 + (b) * 2 + (h)) * HTB)
#define PG8_STAGE2(bufoff, soff, vX, rX, k) do { _Pragma("unroll") for (int _i = 0; _i < 2; ++_i) \
        __builtin_amdgcn_raw_ptr_buffer_load_lds(rs, (PG8_LAS void*)(lds + (bufoff) + ldsw + _i * 8192), 16, (vX)[_i] - ((k) ? (rX)[_i] : 0u), (soff), 0, 0); } while (0)
#define PG8_LDA(dst, b, h) do { _Pragma("unroll") for (int m = 0; m < 4; ++m) _Pragma("unroll") for (int k = 0; k < 2; ++k) dst[m][k] = *(const PG8_LAS bf16x8*)(lds + PG8_SA(b, h) + aoff + m * 2048 + k * 1024); } while (0)
#define PG8_LDB(dst, b, h) do { _Pragma("unroll") for (int n = 0; n < 2; ++n) _Pragma("unroll") for (int k = 0; k < 2; ++k) dst[n][k] = *(const PG8_LAS bf16x8*)(lds + PG8_SB(b, h) + boff + n * 2048 + k * 1024); } while (0)
#define PG8_MMA(ai, bj, At, Bt) do { __builtin_amdgcn_s_setprio(1); _Pragma("unroll") for (int m = 0; m < 4; ++m) _Pragma("unroll") for (int n = 0; n < 2; ++n) _Pragma("unroll") for (int k = 0; k < 2; ++k) \
        acc[ai][bj][m][n] = __builtin_amdgcn_mfma_f32_16x16x32_bf16(Bt[n][k], At[m][k], acc[ai][bj][m][n], 0, 0, 0); __builtin_amdgcn_s_setprio(0); } while (0)
#define PG8_WAIT_V(n) asm volatile("s_waitcnt vmcnt(" #n ")" ::: "memory")
#define PG8_WAIT_VR() asm volatile("s_waitcnt vmcnt(%0)" :: "i"(8 + Epi::NST) : "memory")
#define PG8_WAIT_L(n) asm volatile("s_waitcnt lgkmcnt(" #n ")" ::: "memory")
#define PG8_BAR __builtin_amdgcn_s_barrier()
#define PG8_SCHED __builtin_amdgcn_sched_barrier(0)
    Unit cur, nxt; int ui = 0;
    if (!S.next(0, cur)) return;
    f32x4 acc[2][2][4][2];
#pragma unroll
    for (int a = 0; a < 2; ++a)
#pragma unroll
        for (int b = 0; b < 2; ++b)
#pragma unroll
            for (int m = 0; m < 4; ++m)
#pragma unroll
                for (int n = 0; n < 2; ++n) acc[a][b][m][n] = (f32x4){0.f, 0.f, 0.f, 0.f};
    bf16x8 At[4][2], B0[2][2], B1[2][2];
    int ck = cur.kind;
    unsigned cA = (ck ? gA1 : gA0) + (((unsigned)cur.pm * BM * 2048u) >> ck), cB = (ck ? gB1 : gB0) + (((unsigned)cur.pn * BM * 2048u) >> ck);
    unsigned hs = (unsigned)(HALF * 2048) >> ck;
    PG8_STAGE2(PG8_SB(0, 0), cB, vB, rB, ck); PG8_STAGE2(PG8_SB(0, 1), cB + hs, vB, rB, ck); PG8_STAGE2(PG8_SA(0, 0), cA, vA, rA, ck); PG8_STAGE2(PG8_SA(0, 1), cA + hs, vA, rA, ck);
    if (wr == 1) PG8_BAR;
    PG8_WAIT_V(2); PG8_BAR;
    PG8_STAGE2(PG8_SB(1, 0), cB + kstep, vB, rB, ck); PG8_STAGE2(PG8_SA(1, 0), cA + kstep, vA, rA, ck); PG8_STAGE2(PG8_SB(1, 1), cB + hs + kstep, vB, rB, ck);
    PG8_WAIT_V(6); PG8_BAR;
    for (;;) {
        const bool has_next = S.next(ui + 1, nxt);
        const int nk = has_next ? nxt.kind : ck;
        const unsigned nA = has_next ? (nk ? gA1 : gA0) + (((unsigned)nxt.pm * BM * 2048u) >> nk) : cA, nB = has_next ? (nk ? gB1 : gB0) + (((unsigned)nxt.pn * BM * 2048u) >> nk) : cB;
        const unsigned nhs = (unsigned)(HALF * 2048) >> nk;
        const int nt = 16 >> ck;
#pragma unroll 1
        for (int t = 0; t < nt; t += 2) {
            const bool last = (t == nt - 2);
            const bool relax = (t == 0) && (ui > 0);
            const unsigned a1 = cA + (unsigned)(t + 1) * kstep;
            const unsigned a2 = last ? nA : cA + (unsigned)(t + 2) * kstep, b2 = last ? nB : cB + (unsigned)(t + 2) * kstep;
            const unsigned a3 = a2 + kstep, b3 = b2 + kstep;
            const int k2 = last ? nk : ck; const unsigned hs2 = last ? nhs : hs;
            PG8_LDB(B0, 0, 0); PG8_LDB(B1, 0, 1); PG8_SCHED; PG8_LDA(At, 0, 0); PG8_STAGE2(PG8_SA(1, 1), a1 + hs, vA, rA, ck);
            if (relax) PG8_WAIT_VR(); else PG8_WAIT_V(8);
            PG8_WAIT_L(0); PG8_BAR; PG8_MMA(0, 0, At, B0); PG8_MMA(0, 1, At, B1); PG8_BAR; PG8_SCHED;
            PG8_LDA(At, 0, 1); PG8_STAGE2(PG8_SB(0, 0), b2, vB, rB, k2); PG8_STAGE2(PG8_SB(0, 1), b2 + hs2, vB, rB, k2); PG8_STAGE2(PG8_SA(0, 0), a2, vA, rA, k2);
            if (relax) PG8_WAIT_VR(); else PG8_WAIT_V(8);
            PG8_WAIT_L(0); PG8_BAR; PG8_MMA(1, 0, At, B0); PG8_MMA(1, 1, At, B1); PG8_BAR; PG8_SCHED;
            PG8_LDB(B0, 1, 0); PG8_LDB(B1, 1, 1); PG8_SCHED; PG8_LDA(At, 1, 0); PG8_STAGE2(PG8_SA(0, 1), a2 + hs2, vA, rA, k2);
            PG8_WAIT_V(8); PG8_WAIT_L(0); PG8_BAR; PG8_MMA(0, 0, At, B0); PG8_MMA(0, 1, At, B1); PG8_BAR; PG8_SCHED;
            PG8_LDA(At, 1, 1); PG8_STAGE2(PG8_SB(1, 0), b3, vB, rB, k2); PG8_STAGE2(PG8_SB(1, 1), b3 + hs2, vB, rB, k2); PG8_STAGE2(PG8_SA(1, 0), a3, vA, rA, k2);
            PG8_WAIT_V(8); PG8_WAIT_L(0); PG8_BAR; PG8_MMA(1, 0, At, B0); PG8_MMA(1, 1, At, B1); PG8_BAR; PG8_SCHED;
        }
        if (wr == 0) PG8_BAR;
        E(acc, cur, ui, wr, wc, fr, fq);
        if (!has_next) break;
#pragma unroll
        for (int a = 0; a < 2; ++a)
#pragma unroll
            for (int b = 0; b < 2; ++b)
#pragma unroll
                for (int m = 0; m < 4; ++m)
#pragma unroll
                    for (int n = 0; n < 2; ++n) acc[a][b][m][n] = (f32x4){0.f, 0.f, 0.f, 0.f};
        cur = nxt; cA = nA; cB = nB; ck = nk; hs = nhs; ++ui;
        if (wr == 1) PG8_BAR;
    }
    PG8_WAIT_V(0);
    PG8_BAR;
#undef PG8_SA
#undef PG8_SB
#undef PG8_STAGE2
#undef PG8_LDA
#undef PG8_LDB
#undef PG8_MMA
#undef PG8_WAIT_V
#undef PG8_WAIT_VR
#undef PG8_WAIT_L
#undef PG8_BAR
#undef PG8_SCHED
}
}

constexpr int NWAVES = 8, NTHR = NWAVES * 64;
constexpr int BATCH = 32, SEQ = 2048, D = 1024, M = BATCH * SEQ;
constexpr int NIN = 5632, SSMW = 512, NGRP = 32, NST = 64, GCH = 16, FF = 4096;
constexpr int LCH = 16, NCHUNK = SEQ / LCH;
constexpr int UAK = 384;
constexpr int BCROWS = BATCH * NCHUNK;
constexpr float EPS = 1e-6f;

constexpr size_t MiB = 1u << 20;
constexpr size_t WS_SS2 = 0;
constexpr size_t WS_SS3 = 4 * MiB;
constexpr size_t WS_BIAS = 8 * MiB;
constexpr size_t WS_GINV = 8 * MiB + 32 * 1024;
constexpr size_t WS_RMS = 8 * MiB + 64 * 1024;
constexpr size_t WS_BAR = 8 * MiB + 512 * 1024;
constexpr size_t WS_BT1 = 9 * MiB;
constexpr size_t WS_BT2A = 20 * MiB;
constexpr size_t WS_BT2B = 22 * MiB;
constexpr size_t WS_BT3 = 24 * MiB;
constexpr size_t WS_BT4 = 26 * MiB;
constexpr size_t WS_BT5 = 34 * MiB;
constexpr size_t WS_TZ = 42 * MiB;
constexpr size_t WS_MS = 48 * MiB;
constexpr size_t WS_XN = 64 * MiB;
constexpr size_t WS_Z = 928 * MiB;
constexpr size_t WS_SLOC = 736 * MiB;
constexpr size_t WS_HB = 64 * MiB;
constexpr size_t WS_UA = 192 * MiB;
constexpr size_t WS_CB = 288 * MiB;
constexpr size_t WS_HALO = 416 * MiB, WS_CBH = 424 * MiB;
constexpr size_t WS_GS = 544 * MiB, WS_GC = 672 * MiB;
constexpr size_t WS_YB = 800 * MiB;
constexpr size_t WS_HID = 192 * MiB;
constexpr size_t WS_END = 1024 * MiB;

constexpr int RING_BYTES = 131072;
constexpr int LDS_BYTES = 160 * 1024;

#define GAS __attribute__((address_space(1)))
#define LAS __attribute__((address_space(3)))
typedef unsigned short bf16;
typedef unsigned v4u __attribute__((ext_vector_type(4)));
typedef float f32x4 __attribute__((ext_vector_type(4)));
using pg8::Unit; using pg8::u32x4; using pg8::BM;

struct Args { const float* in[22]; float* out; unsigned char* ws; int ph_lo, ph_hi; };

__device__ __forceinline__ float dpp_shr1(float x) { return __int_as_float(__builtin_amdgcn_update_dpp(0, __float_as_int(x), 0x111, 0xf, 0xf, false)); }
struct EpiG1 {
    static constexpr bool PERM = true, ROWPERM = true; static constexpr int NST = 8;
    bf16 *UA, *CB; unsigned char *GS8, *GC8; const float* bias; const float* convw; const float* convb; float* HALO; float* CBH;
    __device__ __forceinline__ void operator()(const f32x4 (&acc)[2][2][4][2], const Unit& u, int ui, int wr, int wc, int fr, int fq) const {
        asm volatile("" : "+v"(fr), "+v"(fq));
        const int pn = u.pn, cl = wc * 32 + 8 * fq, tok0 = u.pm * BM + wr * 128 + fr * 8;
        if (pn >= 2 && pn < 18) {
            const int q = pn - 2, bcol = pn * 256 + cl, j0 = q * 64 + wc * 16 + fq * 4;
            const f32x4 b_cb = *(const f32x4*)(bias + bcol), b_cc = *(const f32x4*)(bias + bcol + 4), b_cv = *(const f32x4*)(bias + bcol + 128), b_gc = *(const f32x4*)(bias + bcol + 132);
            const f32x4 w0 = *(const f32x4*)(convw + j0), w1 = *(const f32x4*)(convw + D + j0), w2 = *(const f32x4*)(convw + 2 * D + j0), cbi = *(const f32x4*)(convb + j0);
            f32x4 p[8];
#pragma unroll
            for (int ai = 0; ai < 2; ++ai)
#pragma unroll
                for (int m = 0; m < 4; ++m) p[4 * ai + m] = (acc[ai][0][m][1] + b_cc) * (acc[ai][1][m][0] + b_cv);
            f32x4 pm1, pm2;
#pragma unroll
            for (int e = 0; e < 4; ++e) { pm1[e] = dpp_shr1(p[7][e]); pm2[e] = dpp_shr1(p[6][e]); }
            const int hb = tok0 >> 7;
            if (fr == 15) { *(f32x4*)(HALO + ((size_t)hb * 2 + 0) * D + j0) = p[6]; *(f32x4*)(HALO + ((size_t)hb * 2 + 1) * D + j0) = p[7]; }
#pragma unroll
            for (int ai = 0; ai < 2; ++ai)
#pragma unroll
                for (int m = 0; m < 4; ++m) { const int k = 4 * ai + m; const size_t row = (size_t)(tok0 + k);
                    const f32x4 a1 = k >= 1 ? p[k >= 1 ? k - 1 : 0] : pm1, a2 = k >= 2 ? p[k >= 2 ? k - 2 : 0] : (k == 1 ? pm1 : pm2);
                    const f32x4 cbv = acc[ai][0][m][0] + b_cb;
                    const f32x4 cv = cbv * (cbi + w2 * p[k] + w1 * a1 + w0 * a2);
                    pg8::u32x2 w; w.x = pg8::cvt_pk_bf16(cv[0], cv[1]); w.y = pg8::cvt_pk_bf16(cv[2], cv[3]);
                    *(pg8::u32x2*)(CB + row * D + j0) = w;
                    if (k < 2 && fr == 0) *(f32x4*)(CBH + ((size_t)hb * 2 + k) * D + j0) = cbv;
                    const f32x4 gl = acc[ai][1][m][1] + b_gc; unsigned gw8 = 0u;
#pragma unroll
                    for (int e = 0; e < 4; ++e) gw8 = __builtin_amdgcn_cvt_pk_u8_f32(__builtin_rintf(255.0f * pg8::sigmoid_f(gl[e])), e, gw8);
                    *(unsigned*)(GC8 + row * D + j0) = gw8; }
        } else if (pn < 2) {
#pragma unroll
            for (int bj = 0; bj < 2; ++bj) { const int ch = pn * 256 + bj * 128 + cl, gidx = ch >> 4, c0 = ch & 15;
                const f32x4 b0 = *(const f32x4*)(bias + ch), b1 = *(const f32x4*)(bias + ch + 4);
#pragma unroll
                for (int ai = 0; ai < 2; ++ai)
#pragma unroll
                    for (int m = 0; m < 4; ++m) { const int tok = tok0 + 4 * ai + m, bc = tok >> 4, jt = tok & 15;
                        *(u32x4*)(UA + ((size_t)gidx * BCROWS + bc) * UAK + jt * 16 + c0) = pg8::pack8(acc[ai][bj][m][0] + b0, acc[ai][bj][m][1] + b1); } }
        } else {
            const int c0 = (pn - 18) * 256;
#pragma unroll
            for (int bj = 0; bj < 2; ++bj) { const int bcol = pn * 256 + bj * 128 + cl;
                const f32x4 b0 = *(const f32x4*)(bias + bcol), b1 = *(const f32x4*)(bias + bcol + 4);
#pragma unroll
                for (int ai = 0; ai < 2; ++ai)
#pragma unroll
                    for (int m = 0; m < 4; ++m) { const size_t row = (size_t)(tok0 + 4 * ai + m);
                        const f32x4 x0 = acc[ai][bj][m][0] + b0, x1 = acc[ai][bj][m][1] + b1; pg8::u32x2 w; w.x = 0u; w.y = 0u;
#pragma unroll
                        for (int e = 0; e < 4; ++e) { w.x = __builtin_amdgcn_cvt_pk_u8_f32(__builtin_rintf(255.0f * pg8::sigmoid_f(x0[e])), e, w.x); w.y = __builtin_amdgcn_cvt_pk_u8_f32(__builtin_rintf(255.0f * pg8::sigmoid_f(x1[e])), e, w.y); }
                        *(pg8::u32x2*)(GS8 + row * D + c0 + bj * 128 + cl) = w; } }
        }
    }
};
struct EpiS1 {
    static constexpr bool PERM = false, ROWPERM = false; static constexpr int NST = 16;
    float* SLOC;
    __device__ __forceinline__ void operator()(const f32x4 (&acc)[2][2][4][2], const Unit& u, int ui, int wr, int wc, int fr, int fq) const {
        asm volatile("" : "+v"(fr), "+v"(fq));
        const int rb = u.pm * BM + wr * 64 + fr, cl = wc * 32 + 4 * fq;
#pragma unroll
        for (int ai = 0; ai < 2; ++ai)
#pragma unroll
            for (int m = 0; m < 4; ++m) { float* rowp = SLOC + (size_t)(rb + ai * 128 + m * 16) * 128 + cl;
#pragma unroll
                for (int n = 0; n < 2; ++n) *(f32x4*)(rowp + n * 16) = acc[ai][0][m][n]; }
    }
};
struct EpiS3 {
    static constexpr bool PERM = true, ROWPERM = false; static constexpr int NST = 16;
    bf16* Z;
    __device__ __forceinline__ void operator()(const f32x4 (&acc)[2][2][4][2], const Unit& u, int ui, int wr, int wc, int fr, int fq) const {
        asm volatile("" : "+v"(fr), "+v"(fq));
        const int gidx = u.pm >> 4, co0 = (fq & 1) * 8;
#pragma unroll
        for (int ai = 0; ai < 2; ++ai)
#pragma unroll
            for (int m = 0; m < 4; ++m) { const int bc = ((u.pm & 15) * BM) + ai * 128 + wr * 64 + m * 16 + fr;
#pragma unroll
                for (int bj = 0; bj < 2; ++bj) { const int j = bj * 8 + wc * 2 + (fq >> 1);
                    f32x4 x0 = acc[ai][bj][m][0], x1 = acc[ai][bj][m][1];
#pragma unroll
                    for (int e = 0; e < 4; ++e) { x0[e] = pg8::gelu_tanh_f(x0[e]); x1[e] = pg8::gelu_tanh_f(x1[e]); }
                    *(u32x4*)(Z + ((size_t)bc * LCH + j) * SSMW + gidx * 16 + co0) = pg8::pack8(x0, x1); } }
    }
};
__device__ __forceinline__ void unpack_u8x8(const pg8::u32x2& w, f32x4& a, f32x4& b) {
    a = (f32x4){(float)(w.x & 0xffu), (float)((w.x >> 8) & 0xffu), (float)((w.x >> 16) & 0xffu), (float)(w.x >> 24)};
    b = (f32x4){(float)(w.y & 0xffu), (float)((w.y >> 8) & 0xffu), (float)((w.y >> 16) & 0xffu), (float)(w.y >> 24)}; }
struct EpiG2b {
    static constexpr bool PERM = true, ROWPERM = false; static constexpr int NST = 16;
    const unsigned char* GC8; bf16* O;
    __device__ __forceinline__ void operator()(const f32x4 (&acc)[2][2][4][2], const Unit& u, int ui, int wr, int wc, int fr, int fq) const {
        asm volatile("" : "+v"(fr), "+v"(fq));
        const int rb = u.pm * BM + wr * 64 + fr, cb = u.pn * 256 + wc * 32 + 8 * fq;
#pragma unroll
        for (int ai = 0; ai < 2; ++ai)
#pragma unroll
            for (int m = 0; m < 4; ++m) { const size_t off = (size_t)(rb + ai * 128 + m * 16) * D + cb;
#pragma unroll
                for (int bj = 0; bj < 2; ++bj) { const pg8::u32x2 w = *(const pg8::u32x2*)(GC8 + off + bj * 128); f32x4 g0, g1; unpack_u8x8(w, g0, g1);
                    *(u32x4*)(O + off + bj * 128) = pg8::pack8(g0 * (1.0f / 255.0f) * acc[ai][bj][m][0], g1 * (1.0f / 255.0f) * acc[ai][bj][m][1]); } }
    }
};
struct EpiG2a {
    static constexpr bool PERM = true, ROWPERM = false; static constexpr int NST = 8;
    const unsigned char* GS8; const bf16* YBi; bf16* O;
    __device__ __forceinline__ void operator()(const f32x4 (&acc)[2][2][4][2], const Unit& u, int ui, int wr, int wc, int fr, int fq) const {
        asm volatile("" : "+v"(fr), "+v"(fq));
        const int rb = u.pm * BM + wr * 64 + fr, cb = u.pn * 128 + wc * 32 + 8 * fq;
#pragma unroll
        for (int ai = 0; ai < 2; ++ai)
#pragma unroll
            for (int m = 0; m < 4; ++m) { const size_t off = (size_t)(rb + ai * 128 + m * 16) * D + cb;
                const pg8::u32x2 wg = *(const pg8::u32x2*)(GS8 + off); const u32x4 wy = *(const u32x4*)(YBi + off); f32x4 g0, g1, y0, y1; unpack_u8x8(wg, g0, g1); pg8::unpack8(wy, y0, y1); g0 = g0 * (1.0f / 255.0f); g1 = g1 * (1.0f / 255.0f);
                f32x4 a0 = acc[ai][0][m][0], a1 = acc[ai][0][m][1], b0 = acc[ai][1][m][0], b1 = acc[ai][1][m][1];
#pragma unroll
                for (int e = 0; e < 4; ++e) { a0[e] = g0[e] * a0[e] * pg8::sigmoid_f(b0[e]) + y0[e]; a1[e] = g1[e] * a1[e] * pg8::sigmoid_f(b1[e]) + y1[e]; }
                *(u32x4*)(O + off) = pg8::pack8(a0, a1); }
    }
};
struct EpiG2ab {
    static constexpr bool PERM = true, ROWPERM = false; static constexpr int NST = 8;
    EpiG2b e0; EpiG2a e1;
    __device__ __forceinline__ void operator()(const f32x4 (&acc)[2][2][4][2], const Unit& u, int ui, int wr, int wc, int fr, int fq) const {
        if (u.kind == 0) e0(acc, u, ui, wr, wc, fr, fq); else e1(acc, u, ui, wr, wc, fr, fq); }
};
struct EpiRes6 {
    static constexpr bool PERM = true, ROWPERM = false; static constexpr int NST = 16;
    bf16* XH; const float* GINV; const LAS float* RMSL; float* SS;
    __device__ __forceinline__ void operator()(const f32x4 (&acc)[2][2][4][2], const Unit& u, int ui, int wr, int wc, int fr, int fq) const {
        asm volatile("" : "+v"(fr), "+v"(fq));
        const int rt = wr * 64 + fr, cb = u.pn * 256 + wc * 32 + 8 * fq;
        f32x4 gi[2][2];
#pragma unroll
        for (int bj = 0; bj < 2; ++bj) { gi[bj][0] = *(const f32x4*)(GINV + cb + bj * 128); gi[bj][1] = *(const f32x4*)(GINV + cb + bj * 128 + 4); }
#pragma unroll
        for (int ai = 0; ai < 2; ++ai)
#pragma unroll
            for (int m = 0; m < 4; ++m) { const int r = rt + ai * 128 + m * 16; const size_t row = (size_t)(u.pm * BM + r), off = row * D + cb; f32x4 sv = {0.f, 0.f, 0.f, 0.f};
                const float rms = RMSL[ui * 256 + r];
#pragma unroll
                for (int bj = 0; bj < 2; ++bj) { const u32x4 w = *(const u32x4*)(XH + off + bj * 128); f32x4 x0, x1; pg8::unpack8(w, x0, x1);
                    const f32x4 h0 = x0 * rms * gi[bj][0] + acc[ai][bj][m][0], h1 = x1 * rms * gi[bj][1] + acc[ai][bj][m][1];
                    *(u32x4*)(XH + off + bj * 128) = pg8::pack8(h0, h1);
                    sv += h0 * h0; sv += h1 * h1; }
                float s = (sv[0] + sv[1]) + (sv[2] + sv[3]);
                s += __shfl_xor(s, 16); s += __shfl_xor(s, 32);
                if (fq == 0) SS[row * 16 + u.pn * 4 + wc] = s; }
    }
};
struct EpiRes8 {
    static constexpr bool PERM = true, ROWPERM = false; static constexpr int NST = 16;
    bf16* HBio; float* SS;
    __device__ __forceinline__ void operator()(const f32x4 (&acc)[2][2][4][2], const Unit& u, int ui, int wr, int wc, int fr, int fq) const {
        asm volatile("" : "+v"(fr), "+v"(fq));
        const int rb = u.pm * BM + wr * 64 + fr, cb = u.pn * 256 + wc * 32 + 8 * fq;
#pragma unroll
        for (int ai = 0; ai < 2; ++ai)
#pragma unroll
            for (int m = 0; m < 4; ++m) { const size_t row = (size_t)(rb + ai * 128 + m * 16), off = row * D + cb; f32x4 sv = {0.f, 0.f, 0.f, 0.f};
#pragma unroll
                for (int bj = 0; bj < 2; ++bj) { const u32x4 w = *(const u32x4*)(HBio + off + bj * 128); f32x4 x0, x1; pg8::unpack8(w, x0, x1);
                    const f32x4 h0 = x0 + acc[ai][bj][m][0], h1 = x1 + acc[ai][bj][m][1];
                    *(u32x4*)(HBio + off + bj * 128) = pg8::pack8(h0, h1);
                    sv += h0 * h0; sv += h1 * h1; }
                float s = (sv[0] + sv[1]) + (sv[2] + sv[3]);
                s += __shfl_xor(s, 16); s += __shfl_xor(s, 32);
                if (fq == 0) SS[row * 16 + u.pn * 4 + wc] = s; }
    }
};
struct EpiG4 {
    static constexpr bool PERM = true, ROWPERM = false; static constexpr int NST = 16;
    bf16* HID; const LAS float* RI2;
    __device__ __forceinline__ void operator()(const f32x4 (&acc)[2][2][4][2], const Unit& u, int ui, int wr, int wc, int fr, int fq) const {
        asm volatile("" : "+v"(fr), "+v"(fq));
        const int rt = wr * 64 + fr, cb = u.pn * 256 + wc * 32 + 8 * fq;
#pragma unroll
        for (int ai = 0; ai < 2; ++ai)
#pragma unroll
            for (int m = 0; m < 4; ++m) { const int r = rt + ai * 128 + m * 16; const size_t row = (size_t)(u.pm * BM + r);
                const float ri2 = RI2[ui * 256 + r];
#pragma unroll
                for (int bj = 0; bj < 2; ++bj) { f32x4 x0 = acc[ai][bj][m][0], x1 = acc[ai][bj][m][1], p0, p1;
#pragma unroll
                    for (int e = 0; e < 4; ++e) { p0[e] = pg8::relu_f(x0[e]); p1[e] = pg8::relu_f(x1[e]); }
                    x0 = x0 * p0 * ri2; x1 = x1 * p1 * ri2;
                    __builtin_nontemporal_store(pg8::pack8(x0, x1), (u32x4*)(HID + row * FF + cb + bj * 128)); } }
    }
};

#define XB_TMO      128
#define XB_XCNT(j)  (256  + 64 * (j))
#define XB_XSUB(j)  (1280 + 64 * (j))
#define XB_XGEN(j)  (2304 + 64 * (j))
#define XB_TOP      3328
#define XB_TOPGEN   3392
#define XCD_BAR_WORDS 3456
#define XB_SPIN_CAP (1u << 18)
__device__ __forceinline__ unsigned xb_ld(unsigned* p)              { return __hip_atomic_load(p, __ATOMIC_RELAXED, __HIP_MEMORY_SCOPE_AGENT); }
__device__ __forceinline__ unsigned xb_add(unsigned* p, unsigned v) { return __hip_atomic_fetch_add(p, v, __ATOMIC_RELAXED, __HIP_MEMORY_SCOPE_AGENT); }
__device__ __forceinline__ unsigned xb_xcc_id() { return (unsigned)__builtin_amdgcn_s_getreg((3 << 11) | 20) & 0xFu; }
#define XB_SPIN(cond, bar) do { unsigned _sp = 0; while (cond) { __builtin_amdgcn_s_sleep(1); \
    if ((++_sp & 255u) == 0u) { if (xb_ld(&(bar)[XB_TMO])) break; if (_sp > XB_SPIN_CAP) { atomicAdd(&(bar)[XB_TMO], 1u); break; } } } } while (0)
struct XcdBarrier { unsigned* bar; unsigned x; volatile LAS unsigned* st; };
__device__ __forceinline__ XcdBarrier xcd_barrier_post(unsigned* bar, volatile LAS unsigned* st) {
    XcdBarrier b; b.bar = bar; b.x = xb_xcc_id(); b.st = st;
    if (threadIdx.x == 0) (void)xb_add(&bar[XB_XCNT(b.x)], 1u);
    return b;
}
__device__ __forceinline__ void xcd_barrier_complete(unsigned* bar, unsigned x, unsigned& nloc, unsigned& nx) {
    const unsigned G = gridDim.x * gridDim.y * gridDim.z;
    unsigned sum, cnt, mine, sp = 0u;
    for (;;) {
        sum = 0u; cnt = 0u; mine = 0u;
#pragma unroll
        for (unsigned j = 0; j < 16; ++j) { const unsigned c = xb_ld(&bar[XB_XCNT(j)]); sum += c; cnt += (c > 0u) ? 1u : 0u; mine = (j == x) ? c : mine; }
        if (sum == G) break;
        __builtin_amdgcn_s_sleep(1);
        if ((++sp & 255u) == 0u) { if (xb_ld(&bar[XB_TMO])) break; if (sp > XB_SPIN_CAP) { atomicAdd(&bar[XB_TMO], 1u); break; } }
    }
    nloc = mine > 0u ? mine : 1u; nx = cnt > 0u ? cnt : 1u;
}
__device__ __forceinline__ void xcd_barrier(const XcdBarrier& b) {
    asm volatile("s_waitcnt vmcnt(0)" ::: "memory");
    __syncthreads();
    if (threadIdx.x == 0) {
        unsigned* bar = b.bar;
        __builtin_amdgcn_s_waitcnt(0);
        unsigned nloc = b.st[0], nx = b.st[1];
        if (nloc == 0u) { xcd_barrier_complete(bar, b.x, nloc, nx); b.st[0] = nloc; b.st[1] = nx; }
        const unsigned old = xb_add(&bar[XB_XSUB(b.x)], 1u);
        const unsigned gen = old / nloc;
        if (old + 1u == (gen + 1u) * nloc) {
            __builtin_amdgcn_fence(__ATOMIC_RELEASE, "agent");
            asm volatile("s_waitcnt vmcnt(0)" ::: "memory");
            const unsigned og = xb_add(&bar[XB_TOP], 1u);
            const unsigned tg = og / nx;
            if (og + 1u == (tg + 1u) * nx) xb_add(&bar[XB_TOPGEN], 1u);
            else XB_SPIN(xb_ld(&bar[XB_TOPGEN]) == tg, bar);
            __builtin_amdgcn_fence(__ATOMIC_ACQUIRE, "agent");
            xb_add(&bar[XB_XGEN(b.x)], 1u);
            asm volatile("s_waitcnt vmcnt(0)" ::: "memory");
        } else {
            XB_SPIN(xb_ld(&bar[XB_XGEN(b.x)]) == gen, bar);
            __builtin_amdgcn_fence(__ATOMIC_ACQUIRE, "agent");
            asm volatile("s_waitcnt vmcnt(0)" ::: "memory");
        }
    }
    __syncthreads();
}

__device__ __forceinline__ float wave_sum(float v) {
#pragma unroll
    for (int o = 1; o < 64; o <<= 1) v += __shfl_xor(v, o);
    return v;
}
__device__ __forceinline__ int bt1_src_col(int r);
template <bool BT1MAP = false>
__device__ __forceinline__ void p0_transpose_item(const float* W, int K, int N, bf16* WT, int dst_row0, int src_col0, int k0, const float* kscale, LAS float* scr, int lane) {
    const int kq = lane >> 3, nq = (lane & 7) * 4; f32x4 v[8];
    if (BT1MAP) src_col0 = bt1_src_col(dst_row0 + nq) - nq;
#pragma unroll
    for (int i = 0; i < 8; ++i) v[i] = *(const f32x4*)(W + (size_t)(k0 + 8 * i + kq) * N + src_col0 + nq);
#pragma unroll
    for (int i = 0; i < 8; ++i) { const int kk = 8 * i + kq; const float sc = kscale ? kscale[k0 + kk] : 1.0f;
#pragma unroll
        for (int e = 0; e < 4; ++e) scr[kk * 33 + nq + e] = v[i][e] * sc; }
    asm volatile("s_waitcnt lgkmcnt(0)" ::: "memory");
    const int c = lane & 7;
#pragma unroll
    for (int j = 0; j < 4; ++j) { const int n = (lane >> 3) + 8 * j; const LAS float* sp = scr + (8 * c) * 33 + n;
        v4u o; o.x = pg8::cvt_pk_bf16(sp[0 * 33], sp[1 * 33]); o.y = pg8::cvt_pk_bf16(sp[2 * 33], sp[3 * 33]); o.z = pg8::cvt_pk_bf16(sp[4 * 33], sp[5 * 33]); o.w = pg8::cvt_pk_bf16(sp[6 * 33], sp[7 * 33]);
        *(v4u*)(WT + (size_t)(dst_row0 + n) * K + k0 + 8 * c) = o; }
    asm volatile("s_waitcnt lgkmcnt(0)" ::: "memory");
}
__device__ __forceinline__ int bt1_src_col(int r) {
    if (r < 512) return r;
    if (r >= 4608) return 3584 + (r - 4608);
    const int t = r - 512, q = t >> 8, c = t & 255, bj = c >> 7, wc = (c >> 5) & 3, fq = (c >> 3) & 3, n = (c >> 2) & 1, e = c & 3, T = 2 * bj + n, j = 64 * q + 16 * wc + 4 * fq + e;
    return (T == 0 ? 512 : T == 1 ? 1536 : T == 2 ? 2560 : 4608) + j; }

__global__ void __launch_bounds__(NTHR, 2) fwd_megakernel(Args args) {
    extern __shared__ __attribute__((aligned(16))) unsigned char lds_raw[];
    LAS unsigned char* lds = (LAS unsigned char*)lds_raw;
    const int tid = threadIdx.x, lane = tid & 63, wave = __builtin_amdgcn_readfirstlane(tid >> 6);
    const int G = gridDim.x, bx = blockIdx.x;
    const int vcu = (G % 8 == 0) ? (bx % 8) * (G / 8) + bx / 8 : bx;
    unsigned char* ws = args.ws;
    if (tid < 2) ((LAS unsigned*)(lds + RING_BYTES))[tid] = 0u;
    __syncthreads();
    const XcdBarrier bar = xcd_barrier_post((unsigned*)(ws + WS_BAR), (volatile LAS unsigned*)(lds + RING_BYTES));
    const float* x = args.in[0];
    float* SS2 = (float*)(ws + WS_SS2); float* SS3 = (float*)(ws + WS_SS3); float* BIASP = (float*)(ws + WS_BIAS);
    bf16* BT1 = (bf16*)(ws + WS_BT1); bf16* BT2A = (bf16*)(ws + WS_BT2A); bf16* BT2B = (bf16*)(ws + WS_BT2B); bf16* BT3 = (bf16*)(ws + WS_BT3);
    bf16* BT4 = (bf16*)(ws + WS_BT4); bf16* BT5 = (bf16*)(ws + WS_BT5); bf16* TZ = (bf16*)(ws + WS_TZ); bf16* MS = (bf16*)(ws + WS_MS);
    bf16* XN = (bf16*)(ws + WS_XN); bf16* Z = (bf16*)(ws + WS_Z); float* SLOC = (float*)(ws + WS_SLOC); bf16* HB = (bf16*)(ws + WS_HB);
    bf16* UA = (bf16*)(ws + WS_UA); bf16* CB = (bf16*)(ws + WS_CB); float* HALO = (float*)(ws + WS_HALO); float* CBH = (float*)(ws + WS_CBH); unsigned char* GS8 = ws + WS_GS; unsigned char* GC8 = ws + WS_GC; bf16* YB = (bf16*)(ws + WS_YB); float* RMS = (float*)(ws + WS_RMS); float* GINV = (float*)(ws + WS_GINV);
    bf16* HID = (bf16*)(ws + WS_HID);
    const int lo = args.ph_lo, hi = args.ph_hi;
#define IN(k) (lo <= (k) && (k) < hi)
#define SEAM(k) do { if (IN(k) && IN((k) + 1)) xcd_barrier(bar); } while (0)
    const int gw = vcu * NWAVES + wave, NGW = G * NWAVES;

    if (IN(0)) {
        for (int task = bx; task < NGRP * 8; task += G) {
            const int gidx = task >> 3, part = task & 7;
            LAS float* L = (LAS float*)lds;
            LAS float* APR = L; LAS float* API = L + 17 * 64; LAS float* BBR = L + 2 * 17 * 64; LAS float* BBI = BBR + 1024; LAS float* CTR = BBI + 1024; LAS float* CTI = CTR + 1024; LAS float* KT = CTI + 1024;
            const float* lam_re = args.in[4] + gidx * 64; const float* lam_im = args.in[5] + gidx * 64; const float dt = expf(args.in[6][gidx]);
            const float* bre = args.in[7] + gidx * 1024; const float* bim = args.in[8] + gidx * 1024; const float* cre = args.in[9] + gidx * 1024; const float* cim = args.in[10] + gidx * 1024;
            __syncthreads();
            if (tid < 64) { const int n = tid; const float lr = lam_re[n], li = lam_im[n];
                const float xm = lr * dt, mag = expf(xm), th = li * dt; const float sn = sinf(th), cs = cosf(th), sh = sinf(0.5f * th);
                const float ar = mag * cs, aim = mag * sn;
                const float er = expm1f(xm) * cs - 2.0f * sh * sh, ei = aim, den = lr * lr + li * li;
                const float qr = (er * lr + ei * li) / den, qi = (ei * lr - er * li) / den;
                float pr = 1.f, pi = 0.f;
                for (int k = 0; k <= 16; ++k) { APR[k * 64 + n] = pr; API[k * 64 + n] = pi; const float t = pr * ar - pi * aim; pi = pr * aim + pi * ar; pr = t; }
                for (int ci = 0; ci < 16; ++ci) { const float br = bre[n * 16 + ci], bi = bim[n * 16 + ci]; BBR[n * 16 + ci] = qr * br - qi * bi; BBI[n * 16 + ci] = qr * bi + qi * br; }
            }
            for (int idx = tid; idx < 1024; idx += NTHR) { const int co = idx >> 6, n = idx & 63; CTR[n * 16 + co] = cre[idx]; CTI[n * 16 + co] = cim[idx]; }
            __syncthreads();
            for (int idx = tid; idx < 4096; idx += NTHR) { const int k = idx >> 8, co = (idx >> 4) & 15, ci = idx & 15; float s = 0.f;
                for (int n = 0; n < 64; ++n) { const float cr = CTR[n * 16 + co], cim_ = CTI[n * 16 + co], pr = APR[k * 64 + n], pi = API[k * 64 + n];
                    const float wre = cr * pr - cim_ * pi, wim = cr * pi + cim_ * pr; s += wre * BBR[n * 16 + ci] - wim * BBI[n * 16 + ci]; }
                if (k == 0 && co == ci) s += args.in[11][gidx * 16 + co];
                KT[idx] = s; }
            __syncthreads();
            for (int id = tid; id < 32 * 48; id += NTHR) { const int rr = id / 48, c8 = id % 48, j = part * 2 + (rr >> 4), co = rr & 15; float v[8];
                if (c8 < 32) { const int i = c8 >> 1, ci0 = (c8 & 1) * 8;
#pragma unroll
                    for (int e = 0; e < 8; ++e) v[e] = (i <= j) ? KT[((j - i) & 15) * 256 + co * 16 + ci0 + e] : 0.f;
                } else { const bool im = c8 >= 40; const int n0 = (c8 - (im ? 40 : 32)) * 8;
#pragma unroll
                    for (int e = 0; e < 8; ++e) { const int n = n0 + e; const float cr = CTR[n * 16 + co], cim_ = CTI[n * 16 + co], pr = APR[(j + 1) * 64 + n], pi = API[(j + 1) * 64 + n];
                        v[e] = im ? -(cr * pi + cim_ * pr) : (cr * pr - cim_ * pi); } }
                v4u o; o.x = pg8::cvt_pk_bf16(v[0], v[1]); o.y = pg8::cvt_pk_bf16(v[2], v[3]); o.z = pg8::cvt_pk_bf16(v[4], v[5]); o.w = pg8::cvt_pk_bf16(v[6], v[7]);
                *(v4u*)(TZ + ((size_t)(gidx * 256 + part * 32 + rr)) * UAK + c8 * 8) = o; }
            { const int rr = tid >> 5, c8 = tid & 31, rho = part * 16 + rr, im = rho >> 6, n = rho & 63, i = c8 >> 1, ci0 = (c8 & 1) * 8; float v[8];
                const float pr = APR[(15 - i) * 64 + n], pi = API[(15 - i) * 64 + n];
#pragma unroll
                for (int e = 0; e < 8; ++e) { const float br = BBR[n * 16 + ci0 + e], bi = BBI[n * 16 + ci0 + e]; v[e] = im ? (pr * bi + pi * br) : (pr * br - pi * bi); }
                v4u o; o.x = pg8::cvt_pk_bf16(v[0], v[1]); o.y = pg8::cvt_pk_bf16(v[2], v[3]); o.z = pg8::cvt_pk_bf16(v[4], v[5]); o.w = pg8::cvt_pk_bf16(v[6], v[7]);
                *(v4u*)(MS + ((size_t)(gidx * 128 + rho)) * 256 + c8 * 8) = o; }
            __syncthreads();
        }
        for (int i = bx * NTHR + tid; i < 128 * 256 / 8; i += G * NTHR) *(v4u*)(MS + (size_t)4096 * 256 + (size_t)i * 8) = (v4u){0u, 0u, 0u, 0u};
        for (int i = bx * NTHR + tid; i < NIN; i += G * NTHR) BIASP[i] = args.in[3][bt1_src_col(i)];
        for (int i = bx * NTHR + tid; i < D; i += G * NTHR) GINV[i] = 1.0f / args.in[1][i];
        __syncthreads();
        {
            LAS float* scr = (LAS float*)(lds + wave * 16384);
            constexpr int I1 = (D / 64) * (NIN / 32), I2A = (SSMW / 64) * (2048 / 32), I2B = (D / 64) * (D / 32), I3 = I2B, I4 = (D / 64) * (FF / 32), I5 = (FF / 64) * (D / 32);
#define P0_LOOP(base, cnt) for (int r = ((gw - (base)) % NGW + NGW) % NGW; r < (cnt); r += NGW)
            P0_LOOP(0, I1) { const int nblk = NIN / 32, kb = r / nblk, nb = r % nblk; p0_transpose_item<true>(args.in[2], D, NIN, BT1, nb * 32, 0, kb * 64, nullptr, scr, lane); }
            P0_LOOP(I1, I2A) { const int nblk = 2048 / 32, kb = r / nblk, nb = r % nblk, row0 = nb * 32, t = row0 >> 8, half = (row0 >> 7) & 1, j = row0 & 127;
                if (half) p0_transpose_item(args.in[13], SSMW, D, BT2A, row0, t * 128 + j, kb * 64, nullptr, scr, lane);
                else p0_transpose_item(args.in[12], SSMW, D, BT2A, row0, t * 128 + j, kb * 64, nullptr, scr, lane); }
            P0_LOOP(I1 + I2A, I2B) { const int nblk = D / 32, kb = r / nblk, nb = r % nblk; p0_transpose_item(args.in[16], D, D, BT2B, nb * 32, nb * 32, kb * 64, nullptr, scr, lane); }
            P0_LOOP(I1 + I2A + I2B, I3) { const int nblk = D / 32, kb = r / nblk, nb = r % nblk; p0_transpose_item(args.in[17], D, D, BT3, nb * 32, nb * 32, kb * 64, nullptr, scr, lane); }
            P0_LOOP(I1 + I2A + I2B + I3, I4) { const int nblk = FF / 32, kb = r / nblk, nb = r % nblk; p0_transpose_item(args.in[19], D, FF, BT4, nb * 32, nb * 32, kb * 64, args.in[18], scr, lane); }
            P0_LOOP(I1 + I2A + I2B + I3 + I4, I5) { const int nblk = D / 32, kb = r / nblk, nb = r % nblk; p0_transpose_item(args.in[20], FF, D, BT5, nb * 32, nb * 32, kb * 64, nullptr, scr, lane); }
#undef P0_LOOP
        }
        {
            const f32x4* g4 = (const f32x4*)args.in[1] + 2 * lane; f32x4 gv[2][2];
#pragma unroll
            for (int j = 0; j < 2; ++j) { gv[j][0] = g4[128 * j]; gv[j][1] = g4[128 * j + 1]; }
            for (int m0 = gw * 4; m0 < M; m0 += NGW * 4) {
                f32x4 v[4][2][2]; float s[4];
#pragma unroll
                for (int r = 0; r < 4; ++r) { const f32x4* xr = (const f32x4*)(x + (size_t)(m0 + r) * D) + 2 * lane;
#pragma unroll
                    for (int j = 0; j < 2; ++j) { v[r][j][0] = xr[128 * j]; v[r][j][1] = xr[128 * j + 1]; } }
#pragma unroll
                for (int r = 0; r < 4; ++r) { f32x4 q = v[r][0][0] * v[r][0][0] + v[r][0][1] * v[r][0][1] + v[r][1][0] * v[r][1][0] + v[r][1][1] * v[r][1][1]; s[r] = (q[0] + q[1]) + (q[2] + q[3]); }
#pragma unroll
                for (int o = 1; o < 64; o <<= 1) {
#pragma unroll
                    for (int r = 0; r < 4; ++r) s[r] += __shfl_xor(s[r], o); }
#pragma unroll
                for (int r = 0; r < 4; ++r) { const float rms = sqrtf(s[r] * (1.0f / D) + EPS), ri = 1.0f / rms; if (lane == 0) RMS[m0 + r] = rms; u32x4* o16 = (u32x4*)(XN + (size_t)(m0 + r) * D) + lane;
#pragma unroll
                    for (int j = 0; j < 2; ++j) o16[64 * j] = pg8::pack8(v[r][j][0] * ri * gv[j][0], v[r][j][1] * ri * gv[j][1]); }
            }
        }
    }
    SEAM(0);

    if (IN(1)) {
        pg8::Gemm g{ws, (unsigned)WS_XN, (unsigned)WS_BT1, D, D, D}; pg8::StaticOrder S; S.init(M, NIN, G, bx);
        EpiG1 E{UA, CB, GS8, GC8, BIASP, args.in[14], args.in[15], HALO, CBH};
        pg8::gemm_phase<EpiG1, pg8::StaticOrder>(lds, g, S, E);
    }
    SEAM(1);

    if (IN(2)) {
        { pg8::Gemm g{ws, (unsigned)WS_UA, (unsigned)WS_MS, UAK, 256, 256}; pg8::GroupOrder S{512, G, bx, 128}; EpiS1 E{SLOC};
          pg8::gemm_phase<EpiS1, pg8::GroupOrder>(lds, g, S, E); }
        asm volatile("s_waitcnt vmcnt(0)" ::: "memory"); __syncthreads();
        if (tid < 256) for (int L = bx + (tid >> 7) * G; L < 512; L += 2 * G) {
            const int n = tid & 63, b = 2 * (L & 15) + ((tid >> 6) & 1), gidx = L >> 4;
            const float lr = args.in[4][gidx * 64 + n], li = args.in[5][gidx * 64 + n], dt = expf(args.in[6][gidx]);
            const float mag = expf(lr * dt * 16.0f), th = li * dt; float ar = cosf(th), ai = sinf(th);
#pragma unroll
            for (int q = 0; q < 4; ++q) { const float t = ar * ar - ai * ai; ai = 2.0f * ar * ai; ar = t; }
            ar *= mag; ai *= mag;
            const float* sl = SLOC + ((size_t)gidx * BCROWS + b * NCHUNK) * 128 + n; bf16* ua = UA + ((size_t)gidx * BCROWS + b * NCHUNK) * UAK + 256 + n;
            float sr = 0.f, si = 0.f;
            for (int c0 = 0; c0 < NCHUNK; c0 += 8) { float lre[8], lim[8];
#pragma unroll
                for (int q = 0; q < 8; ++q) { lre[q] = sl[(size_t)(c0 + q) * 128]; lim[q] = sl[(size_t)(c0 + q) * 128 + 64]; }
#pragma unroll
                for (int q = 0; q < 8; ++q) { ua[(size_t)(c0 + q) * UAK] = (bf16)(pg8::cvt_pk_bf16(sr, 0.f) & 0xffffu); ua[(size_t)(c0 + q) * UAK + 64] = (bf16)(pg8::cvt_pk_bf16(si, 0.f) & 0xffffu);
                    const float t = ar * sr - ai * si + lre[q]; si = ar * si + ai * sr + lim[q]; sr = t; } }
        }
        asm volatile("s_waitcnt vmcnt(0)" ::: "memory"); __syncthreads();
        { pg8::Gemm g{ws, (unsigned)WS_UA, (unsigned)WS_TZ, UAK, UAK, UAK}; pg8::GroupOrder S{512, G, bx, 256}; EpiS3 E{Z};
          pg8::gemm_phase<EpiS3, pg8::GroupOrder>(lds, g, S, E); }
        {
            const float* cw = args.in[14];
            for (int it = bx * NTHR + tid; it < (M / 128) * (D / 4); it += G * NTHR) { const int hb = it >> 8, c = (it & 255) * 4;
                if (((hb * 128) & (SEQ - 1)) == 0) continue;
                const f32x4 m2 = *(const f32x4*)(HALO + ((size_t)(hb - 1) * 2 + 0) * D + c), m1 = *(const f32x4*)(HALO + ((size_t)(hb - 1) * 2 + 1) * D + c);
                const f32x4 c0 = *(const f32x4*)(CBH + ((size_t)hb * 2 + 0) * D + c), c1 = *(const f32x4*)(CBH + ((size_t)hb * 2 + 1) * D + c);
                const f32x4 w0 = *(const f32x4*)(cw + c), w1 = *(const f32x4*)(cw + D + c);
                bf16* r0 = CB + (size_t)hb * 128 * D + c; bf16* r1 = r0 + D;
                const pg8::u32x2 a0 = *(const pg8::u32x2*)r0, a1 = *(const pg8::u32x2*)r1;
                const f32x4 v0 = (f32x4){pg8::bf_lo(a0.x), pg8::bf_hi(a0.x), pg8::bf_lo(a0.y), pg8::bf_hi(a0.y)} + c0 * (w0 * m2 + w1 * m1);
                const f32x4 v1 = (f32x4){pg8::bf_lo(a1.x), pg8::bf_hi(a1.x), pg8::bf_lo(a1.y), pg8::bf_hi(a1.y)} + c1 * (w0 * m1);
                pg8::u32x2 o0, o1; o0.x = pg8::cvt_pk_bf16(v0[0], v0[1]); o0.y = pg8::cvt_pk_bf16(v0[2], v0[3]); o1.x = pg8::cvt_pk_bf16(v1[0], v1[1]); o1.y = pg8::cvt_pk_bf16(v1[2], v1[3]);
                *(pg8::u32x2*)r0 = o0; *(pg8::u32x2*)r1 = o1; }
        }
        }
    SEAM(2);

    if (IN(3)) {
        pg8::G2Order S; S.base.init(M, D, G, bx);
        EpiG2ab E{EpiG2b{GC8, YB}, EpiG2a{GS8, YB, YB}};
        pg8::gemm_phase_multi<EpiG2ab, pg8::G2Order>(lds, ws, (unsigned)WS_CB, (unsigned)WS_BT2B, (unsigned)WS_Z, (unsigned)WS_BT2A, S, E);
    }
    SEAM(3);

    if (IN(4)) {
        pg8::Gemm g{ws, (unsigned)WS_YB, (unsigned)WS_BT3, D, D, D}; pg8::StaticOrder S; S.init(M, D, G, bx);
        LAS float* RMSL = (LAS float*)(lds + RING_BYTES + 256);
        { Unit u; for (int i = 0; i < 16 && S.next(i, u); ++i) if (tid < 256) RMSL[i * 256 + tid] = RMS[(size_t)u.pm * BM + tid];
          __syncthreads(); }
        EpiRes6 E{XN, GINV, RMSL, SS2};
        pg8::gemm_phase<EpiRes6, pg8::StaticOrder>(lds, g, S, E);
    }
    SEAM(4);

    if (IN(5)) {
        pg8::Gemm g{ws, (unsigned)WS_HB, (unsigned)WS_BT4, D, D, D}; pg8::StaticOrder S; S.init(M, FF, G, bx);
        LAS float* RI2 = (LAS float*)(lds + RING_BYTES + 256);
        { Unit u; const int r = tid >> 1, hf = tid & 1;
          for (int i = 0; i < 16 && S.next(i, u); ++i) { const float* sp = SS2 + ((size_t)u.pm * BM + r) * 16 + hf * 8; const f32x4 a = *(const f32x4*)sp, b = *(const f32x4*)(sp + 4);
              float sm = ((a[0] + a[1]) + (a[2] + a[3])) + ((b[0] + b[1]) + (b[2] + b[3])); sm += __shfl_xor(sm, 1);
              if (hf == 0) RI2[i * 256 + r] = 1.0f / (sm * (1.0f / D) + EPS); }
          __syncthreads(); }
        EpiG4 E{HID, RI2};
        pg8::gemm_phase<EpiG4, pg8::StaticOrder>(lds, g, S, E);
    }
    SEAM(5);

    if (IN(6)) {
        pg8::Gemm g{ws, (unsigned)WS_HID, (unsigned)WS_BT5, FF, FF, FF}; pg8::StaticOrder S; S.init(M, D, G, bx); EpiRes8 E{HB, SS3};
        pg8::gemm_phase<EpiRes8, pg8::StaticOrder>(lds, g, S, E);
    }
    SEAM(6);

    if (IN(7)) {
        const f32x4* g4 = (const f32x4*)args.in[21] + 2 * lane; f32x4 gv[2][2];
#pragma unroll
        for (int j = 0; j < 2; ++j) { gv[j][0] = g4[128 * j]; gv[j][1] = g4[128 * j + 1]; }
        for (int m = gw; m < M; m += NGW) {
            float s = (lane < 16) ? SS3[(size_t)m * 16 + lane] : 0.f; s = wave_sum(s);
            const float ri = 1.0f / sqrtf(s * (1.0f / D) + EPS);
            const u32x4* hrow = (const u32x4*)(HB + (size_t)m * D) + lane; f32x4* orow = (f32x4*)(args.out + (size_t)m * D) + 2 * lane;
#pragma unroll
            for (int j = 0; j < 2; ++j) { f32x4 h0, h1; pg8::unpack8(hrow[64 * j], h0, h1); orow[128 * j] = h0 * ri * gv[j][0]; orow[128 * j + 1] = h1 * ri * gv[j][1]; }
        }
    }
#undef IN
#undef SEAM
}

extern "C" void kernel_launch(void* const* d_in, const int* in_sizes, int n_in, void* d_out, int out_size, void* d_ws, size_t ws_size, hipStream_t stream) {
    static int grid = 0;
    if (grid == 0) {
        if (n_in != 22 || in_sizes[0] != M * D || out_size != M * D || ws_size < WS_END) { fprintf(stderr, "kernel_launch: unexpected shapes: n_in %d in0 %d out %d ws %zu (need %zu)\n", n_in, n_in > 0 ? in_sizes[0] : -1, out_size, ws_size, (size_t)WS_END); grid = -1; return; }
        int dev = 0, cus = 0, per_cu = 0;
        if (hipGetDevice(&dev) != hipSuccess || hipDeviceGetAttribute(&cus, hipDeviceAttributeMultiprocessorCount, dev) != hipSuccess) { fprintf(stderr, "kernel_launch: device query failed\n"); grid = -1; return; }
        if (hipFuncSetAttribute((const void*)fwd_megakernel, hipFuncAttributeMaxDynamicSharedMemorySize, LDS_BYTES) != hipSuccess) { fprintf(stderr, "kernel_launch: hipFuncSetAttribute failed\n"); grid = -1; return; }
        if (hipOccupancyMaxActiveBlocksPerMultiprocessor(&per_cu, (const void*)fwd_megakernel, NTHR, LDS_BYTES) != hipSuccess || per_cu < 1) { fprintf(stderr, "kernel_launch: occupancy query says %d blocks per CU\n", per_cu); (void)hipGetLastError(); grid = -1; return; }
        grid = cus;
    }
    if (grid < 0) return;
    if (hipMemsetAsync((char*)d_ws + WS_BAR, 0, 16384, stream) != hipSuccess) { fprintf(stderr, "kernel_launch: memset of the barrier words failed\n"); return; }
    Args a{};
    for (int i = 0; i < 22; ++i) a.in[i] = (const float*)d_in[i];
    a.out = (float*)d_out; a.ws = (unsigned char*)d_ws;
#if MK_PER_PHASE
    for (int p = 0; p < 8; ++p) { a.ph_lo = p; a.ph_hi = p + 1; void* kargs[] = {&a};
        hipError_t e = hipLaunchCooperativeKernel((const void*)fwd_megakernel, dim3(grid), dim3(NTHR), kargs, LDS_BYTES, stream);
        if (e != hipSuccess) { fprintf(stderr, "kernel_launch: phase %d launch failed: %s\n", p, hipGetErrorString(e)); break; } }
#else
    a.ph_lo = 0; a.ph_hi = 8; void* kargs[] = {&a};
    hipError_t e = hipLaunchCooperativeKernel((const void*)fwd_megakernel, dim3(grid), dim3(NTHR), kargs, LDS_BYTES, stream);
    if (e != hipSuccess) fprintf(stderr, "kernel_launch: cooperative launch failed: %s (grid %d)\n", hipGetErrorString(e), grid);
#endif
}
```

```cpp
#include <hip/hip_runtime.h>
#include <cstdio>
#include <cstdint>

#ifndef MK_PER_PHASE
#define MK_PER_PHASE 0
#endif

namespace pg8 {
#define PG8_LAS __attribute__((address_space(3)))
typedef unsigned short bf16_t;
typedef short bf16x8 __attribute__((ext_vector_type(8)));
typedef float f32x4 __attribute__((ext_vector_type(4)));
typedef unsigned u32x4 __attribute__((ext_vector_type(4)));
typedef unsigned u32x2 __attribute__((ext_vector_type(2)));
constexpr int BM = 256, BK = 64, HALF = 128, HTB = HALF * BK * 2  , STAGE_BYTES = 8 * HTB, NXCD = 8, WGM = 8;

__host__ __device__ __forceinline__ int lds_byte(int r, int c) { const int st = (r >> 4) * 2 + (c >> 5), rr = r & 15, cc = c & 31, ob = rr * 64 + cc * 2; return st * 1024 + (ob ^ (((ob >> 9) & 1) << 5)); }
__host__ __device__ __forceinline__ void stage_rc(int b, int& R, int& C) { const int st = b / 1024, sb = b % 1024, swz = sb ^ (((sb >> 9) & 1) << 5); R = (st >> 1) * 16 + swz / 64; C = (st & 1) * 32 + (swz % 64) / 2; }
__host__ __device__ __forceinline__ int perm32(int rho) { const int n = rho >> 4, i = rho & 15; return 8 * (i >> 2) + 4 * n + (i & 3); }

struct Unit { int pm, pn, kind; };
struct Gemm { const unsigned char* ws; unsigned Aoff, Boff; int lda, ldb, K; };
#define PG8_RSRC(base) __builtin_amdgcn_make_buffer_rsrc((void*)(base), 0, 0x7fffffff, 0x00020000)

struct StaticOrder {
    int nM, nN, nwg, G, c;
    __device__ void init(int M, int N, int G_, int c_) { nM = M / BM; nN = N / BM; nwg = nM * nN; G = G_; c = c_; }
    __device__ bool next(int i, Unit& u) const {
        const long L = (long)i * G + c; if (L >= nwg) return false;
        int wgid = (int)L; { const int q = nwg / NXCD, r = nwg % NXCD, xcd = wgid % NXCD, off = wgid / NXCD; wgid = (xcd < r ? xcd * (q + 1) : r * (q + 1) + (xcd - r) * q) + off; }
        const int nig = WGM * nN, gid = wgid / nig, fm = gid * WGM, gsz = (nM - fm) < WGM ? (nM - fm) : WGM;
        u.pm = fm + ((wgid % nig) % gsz); u.pn = (wgid % nig) / gsz; u.kind = 0; return true;
    }
    __device__ __forceinline__ size_t arow(const Unit& u) const { return (size_t)u.pm * BM; }
    __device__ __forceinline__ size_t brow(const Unit& u) const { return (size_t)u.pn * BM; }
};
struct GroupOrder {
    int nunits, G, c, brows;
    __device__ bool next(int i, Unit& u) const { if (i >= 2 || G != 256) return false; u.pm = (c >> 3) * 16 + 2 * (c & 7) + i; u.pn = 0; u.kind = 0; return true; }
    __device__ __forceinline__ size_t arow(const Unit& u) const { return (size_t)u.pm * BM; }
    __device__ __forceinline__ size_t brow(const Unit& u) const { return (size_t)(u.pm >> 4) * brows; }
};

__device__ __forceinline__ unsigned cvt_pk_bf16(float lo, float hi) { unsigned r; asm volatile("v_cvt_pk_bf16_f32 %0, %1, %2" : "=v"(r) : "v"(lo), "v"(hi)); return r; }
__device__ __forceinline__ float bf_lo(unsigned w) { return __uint_as_float(w << 16); }
__device__ __forceinline__ float bf_hi(unsigned w) { return __uint_as_float(w & 0xffff0000u); }
__device__ __forceinline__ float relu_f(float x) { float r; asm("v_max_f32 %0, 0, %1" : "=v"(r) : "v"(x)); return r; }
__device__ __forceinline__ float sigmoid_f(float x) { return __builtin_amdgcn_rcpf(1.0f + __builtin_amdgcn_exp2f(-1.4426950409f * x)); }
__device__ __forceinline__ float gelu_tanh_f(float x) { const float z = x * (1.0f + 0.044715f * x * x); return x * __builtin_amdgcn_rcpf(1.0f + __builtin_amdgcn_exp2f(-2.3022081981f * z)); }
__device__ __forceinline__ u32x4 pack8(const f32x4& a, const f32x4& b) { u32x4 w; w.x = cvt_pk_bf16(a[0], a[1]); w.y = cvt_pk_bf16(a[2], a[3]); w.z = cvt_pk_bf16(b[0], b[1]); w.w = cvt_pk_bf16(b[2], b[3]); return w; }
__device__ __forceinline__ void unpack8(const u32x4& w, f32x4& a, f32x4& b) { a = (f32x4){bf_lo(w.x), bf_hi(w.x), bf_lo(w.y), bf_hi(w.y)}; b = (f32x4){bf_lo(w.z), bf_hi(w.z), bf_lo(w.w), bf_hi(w.w)}; }

template <class Epi, class Sched>
__device__ __forceinline__ void gemm_phase(PG8_LAS unsigned char* lds, const Gemm g, const Sched& S, const Epi& E) {
    const int tid = threadIdx.x, wid = __builtin_amdgcn_readfirstlane(tid >> 6), lane = tid & 63, wr = wid >> 2, wc = wid & 3, fr = lane & 15, fq = lane >> 4;
    const int nt = g.K / BK;
    unsigned voffA[2], voffB[2];
#pragma unroll
    for (int i = 0; i < 2; ++i) { int R, C; stage_rc(tid * 16 + i * 8192, R, C); const int Rb = Epi::PERM ? ((R & ~31) + perm32(R & 31)) : R;
        const int Ra = Epi::ROWPERM ? (128 * (R >> 6) + 8 * (R & 15) + ((R >> 4) & 3)) : R;
        voffA[i] = (unsigned)(Ra * g.lda + C) * 2u; voffB[i] = (unsigned)(Rb * g.ldb + C) * 2u; }
    const __amdgpu_buffer_rsrc_t rs = PG8_RSRC(g.ws);
    const unsigned kstep = (unsigned)(BK * 2);
    const unsigned hstepA = (unsigned)(Epi::ROWPERM ? 4 : HALF) * g.lda * 2, hstepB = (unsigned)HALF * g.ldb * 2;
    const unsigned ldsw = (unsigned)wid * 1024u;
    const int aoff = lds_byte(wr * 64 + fr, fq * 8), boff = lds_byte(wc * 32 + fr, fq * 8);
#define PG8_SA(b, h) (((b) * 2 + (h)) * HTB)
#define PG8_SB(b, h) ((4 + (b) * 2 + (h)) * HTB)
#define PG8_STAGE(bufoff, soff, voff) do { _Pragma("unroll") for (int _i = 0; _i < 2; ++_i) \
        __builtin_amdgcn_raw_ptr_buffer_load_lds(rs, (PG8_LAS void*)(lds + (bufoff) + ldsw + _i * 8192), 16, (voff)[_i], (soff), 0, 0); } while (0)
#define PG8_LDA(dst, b, h) do { _Pragma("unroll") for (int m = 0; m < 4; ++m) _Pragma("unroll") for (int k = 0; k < 2; ++k) dst[m][k] = *(const PG8_LAS bf16x8*)(lds + PG8_SA(b, h) + aoff + m * 2048 + k * 1024); } while (0)
#define PG8_LDB(dst, b, h) do { _Pragma("unroll") for (int n = 0; n < 2; ++n) _Pragma("unroll") for (int k = 0; k < 2; ++k) dst[n][k] = *(const PG8_LAS bf16x8*)(lds + PG8_SB(b, h) + boff + n * 2048 + k * 1024); } while (0)
#define PG8_MMA(ai, bj, At, Bt) do { __builtin_amdgcn_s_setprio(1); _Pragma("unroll") for (int m = 0; m < 4; ++m) _Pragma("unroll") for (int n = 0; n < 2; ++n) _Pragma("unroll") for (int k = 0; k < 2; ++k) \
        acc[ai][bj][m][n] = __builtin_amdgcn_mfma_f32_16x16x32_bf16(Bt[n][k], At[m][k], acc[ai][bj][m][n], 0, 0, 0); __builtin_amdgcn_s_setprio(0); } while (0)
#define PG8_WAIT_V(n) asm volatile("s_waitcnt vmcnt(" #n ")" ::: "memory")
#define PG8_WAIT_VR() asm volatile("s_waitcnt vmcnt(%0)" :: "i"(8 + Epi::NST) : "memory")
#define PG8_WAIT_L(n) asm volatile("s_waitcnt lgkmcnt(" #n ")" ::: "memory")
#define PG8_BAR __builtin_amdgcn_s_barrier()
#define PG8_SCHED __builtin_amdgcn_sched_barrier(0)
    Unit cur, nxt; int ui = 0;
    if (!S.next(0, cur)) return;
    f32x4 acc[2][2][4][2];
#pragma unroll
    for (int a = 0; a < 2; ++a)
#pragma unroll
        for (int b = 0; b < 2; ++b)
#pragma unroll
            for (int m = 0; m < 4; ++m)
#pragma unroll
                for (int n = 0; n < 2; ++n) acc[a][b][m][n] = (f32x4){0.f, 0.f, 0.f, 0.f};
    bf16x8 At[4][2], B0[2][2], B1[2][2];
    unsigned cA = g.Aoff + (unsigned)(S.arow(cur) * (size_t)g.lda * 2), cB = g.Boff + (unsigned)(S.brow(cur) * (size_t)g.ldb * 2);
    PG8_STAGE(PG8_SB(0, 0), cB, voffB); PG8_STAGE(PG8_SB(0, 1), cB + hstepB, voffB); PG8_STAGE(PG8_SA(0, 0), cA, voffA); PG8_STAGE(PG8_SA(0, 1), cA + hstepA, voffA);
    if (wr == 1) PG8_BAR;
    PG8_WAIT_V(2); PG8_BAR;
    PG8_STAGE(PG8_SB(1, 0), cB + kstep, voffB); PG8_STAGE(PG8_SA(1, 0), cA + kstep, voffA); PG8_STAGE(PG8_SB(1, 1), cB + hstepB + kstep, voffB);
    PG8_WAIT_V(6); PG8_BAR;
    for (;;) {
        const bool has_next = S.next(ui + 1, nxt);
        const unsigned nA = has_next ? g.Aoff + (unsigned)(S.arow(nxt) * (size_t)g.lda * 2) : cA, nB = has_next ? g.Boff + (unsigned)(S.brow(nxt) * (size_t)g.ldb * 2) : cB;
#pragma unroll 1
        for (int t = 0; t < nt; t += 2) {
            const bool last = (t == nt - 2);
            const bool relax = (t == 0) && (ui > 0);
            const unsigned a1 = cA + (unsigned)(t + 1) * kstep;
            const unsigned a2 = last ? nA : cA + (unsigned)(t + 2) * kstep, b2 = last ? nB : cB + (unsigned)(t + 2) * kstep;
            const unsigned a3 = a2 + kstep, b3 = b2 + kstep;
            PG8_LDB(B0, 0, 0); PG8_LDB(B1, 0, 1); PG8_SCHED; PG8_LDA(At, 0, 0); PG8_STAGE(PG8_SA(1, 1), a1 + hstepA, voffA);
            if (relax) PG8_WAIT_VR(); else PG8_WAIT_V(8);
            PG8_WAIT_L(0); PG8_BAR; PG8_MMA(0, 0, At, B0); PG8_MMA(0, 1, At, B1); PG8_BAR; PG8_SCHED;
            PG8_LDA(At, 0, 1); PG8_STAGE(PG8_SB(0, 0), b2, voffB); PG8_STAGE(PG8_SB(0, 1), b2 + hstepB, voffB); PG8_STAGE(PG8_SA(0, 0), a2, voffA);
            if (relax) PG8_WAIT_VR(); else PG8_WAIT_V(8);
            PG8_WAIT_L(0); PG8_BAR; PG8_MMA(1, 0, At, B0); PG8_MMA(1, 1, At, B1); PG8_BAR; PG8_SCHED;
            PG8_LDB(B0, 1, 0); PG8_LDB(B1, 1, 1); PG8_SCHED; PG8_LDA(At, 1, 0); PG8_STAGE(PG8_SA(0, 1), a2 + hstepA, voffA);
            PG8_WAIT_V(8); PG8_WAIT_L(0); PG8_BAR; PG8_MMA(0, 0, At, B0); PG8_MMA(0, 1, At, B1); PG8_BAR; PG8_SCHED;
            PG8_LDA(At, 1, 1); PG8_STAGE(PG8_SB(1, 0), b3, voffB); PG8_STAGE(PG8_SB(1, 1), b3 + hstepB, voffB); PG8_STAGE(PG8_SA(1, 0), a3, voffA);
            PG8_WAIT_V(8); PG8_WAIT_L(0); PG8_BAR; PG8_MMA(1, 0, At, B0); PG8_MMA(1, 1, At, B1); PG8_BAR; PG8_SCHED;
        }
        if (wr == 0) PG8_BAR;
        E(acc, cur, ui, wr, wc, fr, fq);
        if (!has_next) break;
#pragma unroll
        for (int a = 0; a < 2; ++a)
#pragma unroll
            for (int b = 0; b < 2; ++b)
#pragma unroll
                for (int m = 0; m < 4; ++m)
#pragma unroll
                    for (int n = 0; n < 2; ++n) acc[a][b][m][n] = (f32x4){0.f, 0.f, 0.f, 0.f};
        cur = nxt; cA = nA; cB = nB; ++ui;
        if (wr == 1) PG8_BAR;
    }
    PG8_WAIT_V(0);
    PG8_BAR;
#undef PG8_SA
#undef PG8_SB
#undef PG8_STAGE
#undef PG8_LDA
#undef PG8_LDB
#undef PG8_MMA
#undef PG8_WAIT_V
#undef PG8_WAIT_VR
#undef PG8_WAIT_L
#undef PG8_BAR
#undef PG8_SCHED
}

struct G2Order {
    StaticOrder base;
    __device__ bool next(int i, Unit& u) const { const int tg = i / 3, sub = i - 3 * tg; Unit b; if (!base.next(tg, b)) return false;
        u.pm = b.pm; u.kind = sub ? 1 : 0; u.pn = sub ? 2 * b.pn + sub - 1 : b.pn; return true; }
};
template <class Epi, class Sched>
__device__ __forceinline__ void gemm_phase_multi(PG8_LAS unsigned char* lds, const unsigned char* ws, unsigned gA0, unsigned gB0, unsigned gA1, unsigned gB1, const Sched& S, const Epi& E) {
    const int tid = threadIdx.x, wid = __builtin_amdgcn_readfirstlane(tid >> 6), lane = tid & 63, wr = wid >> 2, wc = wid & 3, fr = lane & 15, fq = lane >> 4;
    unsigned vA[2], vB[2], rA[2], rB[2];
#pragma unroll
    for (int i = 0; i < 2; ++i) { int R, C; stage_rc(tid * 16 + i * 8192, R, C); const int Rb = Epi::PERM ? ((R & ~31) + perm32(R & 31)) : R;
        vA[i] = (unsigned)(R * 1024 + C) * 2u; rA[i] = (unsigned)R * 1024u; vB[i] = (unsigned)(Rb * 1024 + C) * 2u; rB[i] = (unsigned)Rb * 1024u; }
    const __amdgpu_buffer_rsrc_t rs = PG8_RSRC(ws);
    const unsigned kstep = (unsigned)(BK * 2);
    const unsigned ldsw = (unsigned)wid * 1024u;
    const int aoff = lds_byte(wr * 64 + fr, fq * 8), boff = lds_byte(wc * 32 + fr, fq * 8);
#define PG8_SA(b, h) (((b) * 2 + (h)) * HTB)
#define PG8_SB(b, h) ((4 + (b) * 2 + (h)) * HTB)
#define PG8_STAGE2(bufoff, soff, vX, rX, k) do { _Pragma("unroll") for (int _i = 0; _i < 2; ++_i) \
        __builtin_amdgcn_raw_ptr_buffer_load_lds(rs, (PG8_LAS void*)(lds + (bufoff) + ldsw + _i * 8192), 16, (vX)[_i] - ((k) ? (rX)[_i] : 0u), (soff), 0, 0); } while (0)
#define PG8_LDA(dst, b, h) do { _Pragma("unroll") for (int m = 0; m < 4; ++m) _Pragma("unroll") for (int k = 0; k < 2; ++k) dst[m][k] = *(const PG8_LAS bf16x8*)(lds + PG8_SA(b, h) + aoff + m * 2048 + k * 1024); } while (0)
#define PG8_LDB(dst, b, h) do { _Pragma("unroll") for (int n = 0; n < 2; ++n) _Pragma("unroll") for (int k = 0; k < 2; ++k) dst[n][k] = *(const PG8_LAS bf16x8*)(lds + PG8_SB(b, h) + boff + n * 2048 + k * 1024); } while (0)
#define PG8_MMA(ai, bj, At, Bt) do { __builtin_amdgcn_s_setprio(1); _Pragma("unroll") for (int m = 0; m < 4; ++m) _Pragma("unroll") for (int n = 0; n < 2; ++n) _Pragma("unroll") for (int k = 0; k < 2; ++k) \
        acc[ai][bj][m][n] = __builtin_amdgcn_mfma_f32_16x16x32_bf16(Bt[n][k], At[m][k], acc[ai][bj][m][n], 0, 0, 0); __builtin_amdgcn_s_setprio(0); } while (0)
#define PG8_WAIT_V(n) asm volatile("s_waitcnt vmcnt(" #n ")" ::: "memory")
#define PG8_WAIT_VR() asm volatile("s_waitcnt vmcnt(%0)" :: "i"(8 + Epi::NST) : "memory")
#define PG8_WAIT_L(n) asm volatile("s_waitcnt lgkmcnt(" #n ")" ::: "memory")
#define PG8_BAR __builtin_amdgcn_s_barrier()
#define PG8_SCHED __builtin_amdgcn_sched_barrier(0)
    Unit cur, nxt; int ui = 0;
    if (!S.next(0, cur)) return;
    f32x4 acc[2][2][4][2];
#pragma unroll
    for (int a = 0; a < 2; ++a)
#pragma unroll
        for (int b = 0; b < 2; ++b)
#pragma unroll
            for (int m = 0; m < 4; ++m)
#pragma unroll
                for (int n = 0; n < 2; ++n) acc[a][b][m][n] = (f32x4){0.f, 0.f, 0.f, 0.f};
    bf16x8 At[4][2], B0[2][2], B1[2][2];
    int ck = cur.kind;
    unsigned cA = (ck ? gA1 : gA0) + (((unsigned)cur.pm * BM * 2048u) >> ck), cB = (ck ? gB1 : gB0) + (((unsigned)cur.pn * BM * 2048u) >> ck);
    unsigned hs = (unsigned)(HALF * 2048) >> ck;
    PG8_STAGE2(PG8_SB(0, 0), cB, vB, rB, ck); PG8_STAGE2(PG8_SB(0, 1), cB + hs, vB, rB, ck); PG8_STAGE2(PG8_SA(0, 0), cA, vA, rA, ck); PG8_STAGE2(PG8_SA(0, 1), cA + hs, vA, rA, ck);
    if (wr == 1) PG8_BAR;
    PG8_WAIT_V(2); PG8_BAR;
    PG8_STAGE2(PG8_SB(1, 0), cB + kstep, vB, rB, ck); PG8_STAGE2(PG8_SA(1, 0), cA + kstep, vA, rA, ck); PG8_STAGE2(PG8_SB(1, 1), cB + hs + kstep, vB, rB, ck);
    PG8_WAIT_V(6); PG8_BAR;
    for (;;) {
        const bool has_next = S.next(ui + 1, nxt);
        const int nk = has_next ? nxt.kind : ck;
        const unsigned nA = has_next ? (nk ? gA1 : gA0) + (((unsigned)nxt.pm * BM * 2048u) >> nk) : cA, nB = has_next ? (nk ? gB1 : gB0) + (((unsigned)nxt.pn * BM * 2048u) >> nk) : cB;
        const unsigned nhs = (unsigned)(HALF * 2048) >> nk;
        const int nt = 16 >> ck;
#pragma unroll 1
        for (int t = 0; t < nt; t += 2) {
            const bool last = (t == nt - 2);
            const bool relax = (t == 0) && (ui > 0);
            const unsigned a1 = cA + (unsigned)(t + 1) * kstep;
            const unsigned a2 = last ? nA : cA + (unsigned)(t + 2) * kstep, b2 = last ? nB : cB + (unsigned)(t + 2) * kstep;
            const unsigned a3 = a2 + kstep, b3 = b2 + kstep;
            const int k2 = last ? nk : ck; const unsigned hs2 = last ? nhs : hs;
            PG8_LDB(B0, 0, 0); PG8_LDB(B1, 0, 1); PG8_SCHED; PG8_LDA(At, 0, 0); PG8_STAGE2(PG8_SA(1, 1), a1 + hs, vA, rA, ck);
            if (relax) PG8_WAIT_VR(); else PG8_WAIT_V(8);
            PG8_WAIT_L(0); PG8_BAR; PG8_MMA(0, 0, At, B0); PG8_MMA(0, 1, At, B1); PG8_BAR; PG8_SCHED;
            PG8_LDA(At, 0, 1); PG8_STAGE2(PG8_SB(0, 0), b2, vB, rB, k2); PG8_STAGE2(PG8_SB(0, 1), b2 + hs2, vB, rB, k2); PG8_STAGE2(PG8_SA(0, 0), a2, vA, rA, k2);
            if (relax) PG8_WAIT_VR(); else PG8_WAIT_V(8);
            PG8_WAIT_L(0); PG8_BAR; PG8_MMA(1, 0, At, B0); PG8_MMA(1, 1, At, B1); PG8_BAR; PG8_SCHED;
            PG8_LDB(B0, 1, 0); PG8_LDB(B1, 1, 1); PG8_SCHED; PG8_LDA(At, 1, 0); PG8_STAGE2(PG8_SA(0, 1), a2 + hs2, vA, rA, k2);
            PG8_WAIT_V(8); PG8_WAIT_L(0); PG8_BAR; PG8_MMA(0, 0, At, B0); PG8_MMA(0, 1, At, B1); PG8_BAR; PG8_SCHED;
            PG8_LDA(At, 1, 1); PG8_STAGE2(PG8_SB(1, 0), b3, vB, rB, k2); PG8_STAGE2(PG8_SB(1, 1), b3 + hs2, vB, rB, k2); PG8_STAGE2(PG8_SA(1, 0), a3, vA, rA, k2);
            PG8_WAIT_V(8); PG8_WAIT_L(0); PG8_BAR; PG8_MMA(1, 0, At, B0); PG8_MMA(1, 1, At, B1); PG8_BAR; PG8_SCHED;
        }
        if (wr == 0) PG8_BAR;
        E(acc, cur, ui, wr, wc, fr, fq);
        if (!has_next) break;
#pragma unroll
        for (int a = 0; a < 2; ++a)
#pragma unroll
            for (int b = 0; b < 2; ++b)
#pragma unroll
                for (int m = 0; m < 4; ++m)
#pragma unroll
                    for (int n = 0; n < 2; ++n) acc[a][b][m][n] = (f32x4){0.f, 0.f, 0.f, 0.f};
        cur = nxt; cA = nA; cB = nB; ck = nk; hs = nhs; ++ui;
        if (wr == 1) PG8_BAR;
    }
    PG8_WAIT_V(0);
    PG8_BAR;
#undef PG8_SA
#undef PG8_SB
#undef PG8_STAGE2
#undef PG8_LDA
#undef PG8_LDB
#undef PG8_MMA
#undef PG8_WAIT_V
#undef PG8_WAIT_VR
#undef PG8_WAIT_L
#undef PG8_BAR
#undef PG8_SCHED
}
}

constexpr int NWAVES = 8, NTHR = NWAVES * 64;
constexpr int BATCH = 32, SEQ = 2048, D = 1024, M = BATCH * SEQ;
constexpr int NIN = 5632, SSMW = 512, NGRP = 32, NST = 64, GCH = 16, FF = 4096;
constexpr int LCH = 16, NCHUNK = SEQ / LCH;
constexpr int UAK = 384;
constexpr int BCROWS = BATCH * NCHUNK;
constexpr float EPS = 1e-6f;

constexpr size_t MiB = 1u << 20;
constexpr size_t WS_SS2 = 0;
constexpr size_t WS_SS3 = 4 * MiB;
constexpr size_t WS_BIAS = 8 * MiB;
constexpr size_t WS_GINV = 8 * MiB + 32 * 1024;
constexpr size_t WS_RMS = 8 * MiB + 64 * 1024;
constexpr size_t WS_BAR = 8 * MiB + 512 * 1024;
constexpr size_t WS_BT1 = 9 * MiB;
constexpr size_t WS_BT2A = 20 * MiB;
constexpr size_t WS_BT2B = 22 * MiB;
constexpr size_t WS_BT3 = 24 * MiB;
constexpr size_t WS_BT4 = 26 * MiB;
constexpr size_t WS_BT5 = 34 * MiB;
constexpr size_t WS_TZ = 42 * MiB;
constexpr size_t WS_MS = 48 * MiB;
constexpr size_t WS_XN = 64 * MiB;
constexpr size_t WS_Z = 928 * MiB;
constexpr size_t WS_SLOC = 736 * MiB;
constexpr size_t WS_HB = 64 * MiB;
constexpr size_t WS_UA = 192 * MiB;
constexpr size_t WS_CB = 288 * MiB;
constexpr size_t WS_HALO = 416 * MiB, WS_CBH = 424 * MiB;
constexpr size_t WS_GS = 544 * MiB, WS_GC = 672 * MiB;
constexpr size_t WS_YB = 800 * MiB;
constexpr size_t WS_HID = 192 * MiB;
constexpr size_t WS_END = 1024 * MiB;

constexpr int RING_BYTES = 131072;
constexpr int LDS_BYTES = 160 * 1024;

#define GAS __attribute__((address_space(1)))
#define LAS __attribute__((address_space(3)))
typedef unsigned short bf16;
typedef unsigned v4u __attribute__((ext_vector_type(4)));
typedef float f32x4 __attribute__((ext_vector_type(4)));
using pg8::Unit; using pg8::u32x4; using pg8::BM;

struct Args { const float* in[22]; float* out; unsigned char* ws; int ph_lo, ph_hi; };

__device__ __forceinline__ float dpp_shr1(float x) { return __int_as_float(__builtin_amdgcn_update_dpp(0, __float_as_int(x), 0x111, 0xf, 0xf, false)); }
struct EpiG1 {
    static constexpr bool PERM = true, ROWPERM = true; static constexpr int NST = 8;
    bf16 *UA, *CB; unsigned char *GS8, *GC8; const float* bias; const float* convw; const float* convb; float* HALO; float* CBH;
    __device__ __forceinline__ void operator()(const f32x4 (&acc)[2][2][4][2], const Unit& u, int ui, int wr, int wc, int fr, int fq) const {
        asm volatile("" : "+v"(fr), "+v"(fq));
        const int pn = u.pn, cl = wc * 32 + 8 * fq, tok0 = u.pm * BM + wr * 128 + fr * 8;
        if (pn >= 2 && pn < 18) {
            const int q = pn - 2, bcol = pn * 256 + cl, j0 = q * 64 + wc * 16 + fq * 4;
            const f32x4 b_cb = *(const f32x4*)(bias + bcol), b_cc = *(const f32x4*)(bias + bcol + 4), b_cv = *(const f32x4*)(bias + bcol + 128), b_gc = *(const f32x4*)(bias + bcol + 132);
            const f32x4 w0 = *(const f32x4*)(convw + j0), w1 = *(const f32x4*)(convw + D + j0), w2 = *(const f32x4*)(convw + 2 * D + j0), cbi = *(const f32x4*)(convb + j0);
            f32x4 p[8];
#pragma unroll
            for (int ai = 0; ai < 2; ++ai)
#pragma unroll
                for (int m = 0; m < 4; ++m) p[4 * ai + m] = (acc[ai][0][m][1] + b_cc) * (acc[ai][1][m][0] + b_cv);
            f32x4 pm1, pm2;
#pragma unroll
            for (int e = 0; e < 4; ++e) { pm1[e] = dpp_shr1(p[7][e]); pm2[e] = dpp_shr1(p[6][e]); }
            const int hb = tok0 >> 7;
            if (fr == 15) { *(f32x4*)(HALO + ((size_t)hb * 2 + 0) * D + j0) = p[6]; *(f32x4*)(HALO + ((size_t)hb * 2 + 1) * D + j0) = p[7]; }
#pragma unroll
            for (int ai = 0; ai < 2; ++ai)
#pragma unroll
                for (int m = 0; m < 4; ++m) { const int k = 4 * ai + m; const size_t row = (size_t)(tok0 + k);
                    const f32x4 a1 = k >= 1 ? p[k >= 1 ? k - 1 : 0] : pm1, a2 = k >= 2 ? p[k >= 2 ? k - 2 : 0] : (k == 1 ? pm1 : pm2);
                    const f32x4 cbv = acc[ai][0][m][0] + b_cb;
                    const f32x4 cv = cbv * (cbi + w2 * p[k] + w1 * a1 + w0 * a2);
                    pg8::u32x2 w; w.x = pg8::cvt_pk_bf16(cv[0], cv[1]); w.y = pg8::cvt_pk_bf16(cv[2], cv[3]);
                    *(pg8::u32x2*)(CB + row * D + j0) = w;
                    if (k < 2 && fr == 0) *(f32x4*)(CBH + ((size_t)hb * 2 + k) * D + j0) = cbv;
                    const f32x4 gl = acc[ai][1][m][1] + b_gc; unsigned gw8 = 0u;
#pragma unroll
                    for (int e = 0; e < 4; ++e) gw8 = __builtin_amdgcn_cvt_pk_u8_f32(__builtin_rintf(255.0f * pg8::sigmoid_f(gl[e])), e, gw8);
                    *(unsigned*)(GC8 + row * D + j0) = gw8; }
        } else if (pn < 2) {
#pragma unroll
            for (int bj = 0; bj < 2; ++bj) { const int ch = pn * 256 + bj * 128 + cl, gidx = ch >> 4, c0 = ch & 15;
                const f32x4 b0 = *(const f32x4*)(bias + ch), b1 = *(const f32x4*)(bias + ch + 4);
#pragma unroll
                for (int ai = 0; ai < 2; ++ai)
#pragma unroll
                    for (int m = 0; m < 4; ++m) { const int tok = tok0 + 4 * ai + m, bc = tok >> 4, jt = tok & 15;
                        *(u32x4*)(UA + ((size_t)gidx * BCROWS + bc) * UAK + jt * 16 + c0) = pg8::pack8(acc[ai][bj][m][0] + b0, acc[ai][bj][m][1] + b1); } }
        } else {
            const int c0 = (pn - 18) * 256;
#pragma unroll
            for (int bj = 0; bj < 2; ++bj) { const int bcol = pn * 256 + bj * 128 + cl;
                const f32x4 b0 = *(const f32x4*)(bias + bcol), b1 = *(const f32x4*)(bias + bcol + 4);
#pragma unroll
                for (int ai = 0; ai < 2; ++ai)
#pragma unroll
                    for (int m = 0; m < 4; ++m) { const size_t row = (size_t)(tok0 + 4 * ai + m);
                        const f32x4 x0 = acc[ai][bj][m][0] + b0, x1 = acc[ai][bj][m][1] + b1; pg8::u32x2 w; w.x = 0u; w.y = 0u;
#pragma unroll
                        for (int e = 0; e < 4; ++e) { w.x = __builtin_amdgcn_cvt_pk_u8_f32(__builtin_rintf(255.0f * pg8::sigmoid_f(x0[e])), e, w.x); w.y = __builtin_amdgcn_cvt_pk_u8_f32(__builtin_rintf(255.0f * pg8::sigmoid_f(x1[e])), e, w.y); }
                        *(pg8::u32x2*)(GS8 + row * D + c0 + bj * 128 + cl) = w; } }
        }
    }
};
struct EpiS1 {
    static constexpr bool PERM = false, ROWPERM = false; static constexpr int NST = 16;
    float* SLOC;
    __device__ __forceinline__ void operator()(const f32x4 (&acc)[2][2][4][2], const Unit& u, int ui, int wr, int wc, int fr, int fq) const {
        asm volatile("" : "+v"(fr), "+v"(fq));
        const int rb = u.pm * BM + wr * 64 + fr, cl = wc * 32 + 4 * fq;
#pragma unroll
        for (int ai = 0; ai < 2; ++ai)
#pragma unroll
            for (int m = 0; m < 4; ++m) { float* rowp = SLOC + (size_t)(rb + ai * 128 + m * 16) * 128 + cl;
#pragma unroll
                for (int n = 0; n < 2; ++n) *(f32x4*)(rowp + n * 16) = acc[ai][0][m][n]; }
    }
};
struct EpiS3 {
    static constexpr bool PERM = true, ROWPERM = false; static constexpr int NST = 16;
    bf16* Z;
    __device__ __forceinline__ void operator()(const f32x4 (&acc)[2][2][4][2], const Unit& u, int ui, int wr, int wc, int fr, int fq) const {
        asm volatile("" : "+v"(fr), "+v"(fq));
        const int gidx = u.pm >> 4, co0 = (fq & 1) * 8;
#pragma unroll
        for (int ai = 0; ai < 2; ++ai)
#pragma unroll
            for (int m = 0; m < 4; ++m) { const int bc = ((u.pm & 15) * BM) + ai * 128 + wr * 64 + m * 16 + fr;
#pragma unroll
                for (int bj = 0; bj < 2; ++bj) { const int j = bj * 8 + wc * 2 + (fq >> 1);
                    f32x4 x0 = acc[ai][bj][m][0], x1 = acc[ai][bj][m][1];
#pragma unroll
                    for (int e = 0; e < 4; ++e) { x0[e] = pg8::gelu_tanh_f(x0[e]); x1[e] = pg8::gelu_tanh_f(x1[e]); }
                    *(u32x4*)(Z + ((size_t)bc * LCH + j) * SSMW + gidx * 16 + co0) = pg8::pack8(x0, x1); } }
    }
};
__device__ __forceinline__ void unpack_u8x8(const pg8::u32x2& w, f32x4& a, f32x4& b) {
    a = (f32x4){(float)(w.x & 0xffu), (float)((w.x >> 8) & 0xffu), (float)((w.x >> 16) & 0xffu), (float)(w.x >> 24)};
    b = (f32x4){(float)(w.y & 0xffu), (float)((w.y >> 8) & 0xffu), (float)((w.y >> 16) & 0xffu), (float)(w.y >> 24)}; }
struct EpiG2b {
    static constexpr bool PERM = true, ROWPERM = false; static constexpr int NST = 16;
    const unsigned char* GC8; bf16* O;
    __device__ __forceinline__ void operator()(const f32x4 (&acc)[2][2][4][2], const Unit& u, int ui, int wr, int wc, int fr, int fq) const {
        asm volatile("" : "+v"(fr), "+v"(fq));
        const int rb = u.pm * BM + wr * 64 + fr, cb = u.pn * 256 + wc * 32 + 8 * fq;
#pragma unroll
        for (int ai = 0; ai < 2; ++ai)
#pragma unroll
            for (int m = 0; m < 4; ++m) { const size_t off = (size_t)(rb + ai * 128 + m * 16) * D + cb;
#pragma unroll
                for (int bj = 0; bj < 2; ++bj) { const pg8::u32x2 w = *(const pg8::u32x2*)(GC8 + off + bj * 128); f32x4 g0, g1; unpack_u8x8(w, g0, g1);
                    *(u32x4*)(O + off + bj * 128) = pg8::pack8(g0 * (1.0f / 255.0f) * acc[ai][bj][m][0], g1 * (1.0f / 255.0f) * acc[ai][bj][m][1]); } }
    }
};
struct EpiG2a {
    static constexpr bool PERM = true, ROWPERM = false; static constexpr int NST = 8;
    const unsigned char* GS8; const bf16* YBi; bf16* O;
    __device__ __forceinline__ void operator()(const f32x4 (&acc)[2][2][4][2], const Unit& u, int ui, int wr, int wc, int fr, int fq) const {
        asm volatile("" : "+v"(fr), "+v"(fq));
        const int rb = u.pm * BM + wr * 64 + fr, cb = u.pn * 128 + wc * 32 + 8 * fq;
#pragma unroll
        for (int ai = 0; ai < 2; ++ai)
#pragma unroll
            for (int m = 0; m < 4; ++m) { const size_t off = (size_t)(rb + ai * 128 + m * 16) * D + cb;
                const pg8::u32x2 wg = *(const pg8::u32x2*)(GS8 + off); const u32x4 wy = *(const u32x4*)(YBi + off); f32x4 g0, g1, y0, y1; unpack_u8x8(wg, g0, g1); pg8::unpack8(wy, y0, y1); g0 = g0 * (1.0f / 255.0f); g1 = g1 * (1.0f / 255.0f);
                f32x4 a0 = acc[ai][0][m][0], a1 = acc[ai][0][m][1], b0 = acc[ai][1][m][0], b1 = acc[ai][1][m][1];
#pragma unroll
                for (int e = 0; e < 4; ++e) { a0[e] = g0[e] * a0[e] * pg8::sigmoid_f(b0[e]) + y0[e]; a1[e] = g1[e] * a1[e] * pg8::sigmoid_f(b1[e]) + y1[e]; }
                *(u32x4*)(O + off) = pg8::pack8(a0, a1); }
    }
};
struct EpiG2ab {
    static constexpr bool PERM = true, ROWPERM = false; static constexpr int NST = 8;
    EpiG2b e0; EpiG2a e1;
    __device__ __forceinline__ void operator()(const f32x4 (&acc)[2][2][4][2], const Unit& u, int ui, int wr, int wc, int fr, int fq) const {
        if (u.kind == 0) e0(acc, u, ui, wr, wc, fr, fq); else e1(acc, u, ui, wr, wc, fr, fq); }
};
struct EpiRes6 {
    static constexpr bool PERM = true, ROWPERM = false; static constexpr int NST = 16;
    bf16* XH; const float* GINV; const LAS float* RMSL; float* SS;
    __device__ __forceinline__ void operator()(const f32x4 (&acc)[2][2][4][2], const Unit& u, int ui, int wr, int wc, int fr, int fq) const {
        asm volatile("" : "+v"(fr), "+v"(fq));
        const int rt = wr * 64 + fr, cb = u.pn * 256 + wc * 32 + 8 * fq;
        f32x4 gi[2][2];
#pragma unroll
        for (int bj = 0; bj < 2; ++bj) { gi[bj][0] = *(const f32x4*)(GINV + cb + bj * 128); gi[bj][1] = *(const f32x4*)(GINV + cb + bj * 128 + 4); }
#pragma unroll
        for (int ai = 0; ai < 2; ++ai)
#pragma unroll
            for (int m = 0; m < 4; ++m) { const int r = rt + ai * 128 + m * 16; const size_t row = (size_t)(u.pm * BM + r), off = row * D + cb; f32x4 sv = {0.f, 0.f, 0.f, 0.f};
                const float rms = RMSL[ui * 256 + r];
#pragma unroll
                for (int bj = 0; bj < 2; ++bj) { const u32x4 w = *(const u32x4*)(XH + off + bj * 128); f32x4 x0, x1; pg8::unpack8(w, x0, x1);
                    const f32x4 h0 = x0 * rms * gi[bj][0] + acc[ai][bj][m][0], h1 = x1 * rms * gi[bj][1] + acc[ai][bj][m][1];
                    *(u32x4*)(XH + off + bj * 128) = pg8::pack8(h0, h1);
                    sv += h0 * h0; sv += h1 * h1; }
                float s = (sv[0] + sv[1]) + (sv[2] + sv[3]);
                s += __shfl_xor(s, 16); s += __shfl_xor(s, 32);
                if (fq == 0) SS[row * 16 + u.pn * 4 + wc] = s; }
    }
};
struct EpiRes8 {
    static constexpr bool PERM = true, ROWPERM = false; static constexpr int NST = 16;
    bf16* HBio; float* SS;
    __device__ __forceinline__ void operator()(const f32x4 (&acc)[2][2][4][2], const Unit& u, int ui, int wr, int wc, int fr, int fq) const {
        asm volatile("" : "+v"(fr), "+v"(fq));
        const int rb = u.pm * BM + wr * 64 + fr, cb = u.pn * 256 + wc * 32 + 8 * fq;
#pragma unroll
        for (int ai = 0; ai < 2; ++ai)
#pragma unroll
            for (int m = 0; m < 4; ++m) { const size_t row = (size_t)(rb + ai * 128 + m * 16), off = row * D + cb; f32x4 sv = {0.f, 0.f, 0.f, 0.f};
#pragma unroll
                for (int bj = 0; bj < 2; ++bj) { const u32x4 w = *(const u32x4*)(HBio + off + bj * 128); f32x4 x0, x1; pg8::unpack8(w, x0, x1);
                    const f32x4 h0 = x0 + acc[ai][bj][m][0], h1 = x1 + acc[ai][bj][m][1];
                    *(u32x4*)(HBio + off + bj * 128) = pg8::pack8(h0, h1);
                    sv += h0 * h0; sv += h1 * h1; }
                float s = (sv[0] + sv[1]) + (sv[2] + sv[3]);
                s += __shfl_xor(s, 16); s += __shfl_xor(s, 32);
                if (fq == 0) SS[row * 16 + u.pn * 4 + wc] = s; }
    }
};
struct EpiG4 {
    static constexpr bool PERM = true, ROWPERM = false; static constexpr int NST = 16;
    bf16* HID; const LAS float* RI2;
    __device__ __forceinline__ void operator()(const f32x4 (&acc)[2][2][4][2], const Unit& u, int ui, int wr, int wc, int fr, int fq) const {
        asm volatile("" : "+v"(fr), "+v"(fq));
        const int rt = wr * 64 + fr, cb = u.pn * 256 + wc * 32 + 8 * fq;
#pragma unroll
        for (int ai = 0; ai < 2; ++ai)
#pragma unroll
            for (int m = 0; m < 4; ++m) { const int r = rt + ai * 128 + m * 16; const size_t row = (size_t)(u.pm * BM + r);
                const float ri2 = RI2[ui * 256 + r];
#pragma unroll
                for (int bj = 0; bj < 2; ++bj) { f32x4 x0 = acc[ai][bj][m][0], x1 = acc[ai][bj][m][1], p0, p1;
#pragma unroll
                    for (int e = 0; e < 4; ++e) { p0[e] = pg8::relu_f(x0[e]); p1[e] = pg8::relu_f(x1[e]); }
                    x0 = x0 * p0 * ri2; x1 = x1 * p1 * ri2;
                    __builtin_nontemporal_store(pg8::pack8(x0, x1), (u32x4*)(HID + row * FF + cb + bj * 128)); } }
    }
};

#define XB_TMO      128
#define XB_XCNT(j)  (256  + 64 * (j))
#define XB_XSUB(j)  (1280 + 64 * (j))
#define XB_XGEN(j)  (2304 + 64 * (j))
#define XB_TOP      3328
#define XB_TOPGEN   3392
#define XB_XSUB2(j) (3456 + 64 * (j))
#define XB_XGEN2(j) (4480 + 64 * (j))
#define XCD_BAR_WORDS 5504
#define XB_SPIN_CAP (1u << 18)
__device__ __forceinline__ unsigned xb_ld(unsigned* p)              { return __hip_atomic_load(p, __ATOMIC_RELAXED, __HIP_MEMORY_SCOPE_AGENT); }
__device__ __forceinline__ unsigned xb_add(unsigned* p, unsigned v) { return __hip_atomic_fetch_add(p, v, __ATOMIC_RELAXED, __HIP_MEMORY_SCOPE_AGENT); }
__device__ __forceinline__ unsigned xb_xcc_id() { return (unsigned)__builtin_amdgcn_s_getreg((3 << 11) | 20) & 0xFu; }
#define XB_SPIN(cond, bar) do { unsigned _sp = 0; while (cond) { __builtin_amdgcn_s_sleep(1); \
    if ((++_sp & 255u) == 0u) { if (xb_ld(&(bar)[XB_TMO])) break; if (_sp > XB_SPIN_CAP) { atomicAdd(&(bar)[XB_TMO], 1u); break; } } } } while (0)
struct XcdBarrier { unsigned* bar; unsigned x; volatile LAS unsigned* st; };
__device__ __forceinline__ XcdBarrier xcd_barrier_post(unsigned* bar, volatile LAS unsigned* st) {
    XcdBarrier b; b.bar = bar; b.x = xb_xcc_id(); b.st = st;
    if (threadIdx.x == 0) { st[2] = b.x; st[3] = xb_add(&bar[XB_XCNT(b.x)], 1u); }
    return b;
}
__device__ __forceinline__ void xcd_barrier_complete(unsigned* bar, unsigned x, unsigned& nloc, unsigned& nx, unsigned& uniform) {
    const unsigned G = gridDim.x * gridDim.y * gridDim.z;
    unsigned sum, cnt, mine, n32, sp = 0u;
    for (;;) {
        sum = 0u; cnt = 0u; mine = 0u; n32 = 0u;
#pragma unroll
        for (unsigned j = 0; j < 16; ++j) { const unsigned c = xb_ld(&bar[XB_XCNT(j)]); sum += c; cnt += (c > 0u) ? 1u : 0u; n32 += (c == 32u) ? 1u : 0u; mine = (j == x) ? c : mine; }
        if (sum == G) break;
        __builtin_amdgcn_s_sleep(1);
        if ((++sp & 255u) == 0u) { if (xb_ld(&bar[XB_TMO])) break; if (sp > XB_SPIN_CAP) { atomicAdd(&bar[XB_TMO], 1u); break; } }
    }
    nloc = mine > 0u ? mine : 1u; nx = cnt > 0u ? cnt : 1u;
    uniform = (sum == 256u && cnt == 8u && n32 == 8u) ? 1u : 0u;
    if (uniform) { for (unsigned j = 8; j < 16; ++j) if (xb_ld(&bar[XB_XCNT(j)]) != 0u) uniform = 0u; }
}
__device__ __forceinline__ void xcd_barrier(const XcdBarrier& b) {
    asm volatile("s_waitcnt vmcnt(0)" ::: "memory");
    __syncthreads();
    if (threadIdx.x == 0) {
        unsigned* bar = b.bar;
        __builtin_amdgcn_s_waitcnt(0);
        unsigned nloc = b.st[0], nx = b.st[1];
        if (nloc == 0u) { unsigned uni = 0u; xcd_barrier_complete(bar, b.x, nloc, nx, uni); b.st[0] = nloc; b.st[1] = nx; b.st[4] = uni; }
        const unsigned old = xb_add(&bar[XB_XSUB(b.x)], 1u);
        const unsigned gen = old / nloc;
        if (old + 1u == (gen + 1u) * nloc) {
            __builtin_amdgcn_fence(__ATOMIC_RELEASE, "agent");
            asm volatile("s_waitcnt vmcnt(0)" ::: "memory");
            const unsigned og = xb_add(&bar[XB_TOP], 1u);
            const unsigned tg = og / nx;
            if (og + 1u == (tg + 1u) * nx) xb_add(&bar[XB_TOPGEN], 1u);
            else XB_SPIN(xb_ld(&bar[XB_TOPGEN]) == tg, bar);
            __builtin_amdgcn_fence(__ATOMIC_ACQUIRE, "agent");
            xb_add(&bar[XB_XGEN(b.x)], 1u);
            asm volatile("s_waitcnt vmcnt(0)" ::: "memory");
        } else {
            XB_SPIN(xb_ld(&bar[XB_XGEN(b.x)]) == gen, bar);
            __builtin_amdgcn_fence(__ATOMIC_ACQUIRE, "agent");
            asm volatile("s_waitcnt vmcnt(0)" ::: "memory");
        }
    }
    __syncthreads();
}

__device__ __forceinline__ void xcd_barrier_local(const XcdBarrier& b) {
    asm volatile("s_waitcnt vmcnt(0)" ::: "memory");
    __syncthreads();
    if (threadIdx.x == 0) {
        unsigned* bar = b.bar;
        __builtin_amdgcn_s_waitcnt(0);
        const unsigned nloc = b.st[0];
        const unsigned old = xb_add(&bar[XB_XSUB2(b.x)], 1u);
        const unsigned gen = old / nloc;
        if (old + 1u == (gen + 1u) * nloc) xb_add(&bar[XB_XGEN2(b.x)], 1u);
        else XB_SPIN(xb_ld(&bar[XB_XGEN2(b.x)]) == gen, bar);
        __builtin_amdgcn_fence(__ATOMIC_ACQUIRE, "agent");
        asm volatile("s_waitcnt vmcnt(0)" ::: "memory");
    }
    __syncthreads();
}

__device__ __forceinline__ float wave_sum(float v) {
#pragma unroll
    for (int o = 1; o < 64; o <<= 1) v += __shfl_xor(v, o);
    return v;
}
__device__ __forceinline__ int bt1_src_col(int r);
template <bool BT1MAP = false>
__device__ __forceinline__ void p0_transpose_item(const float* W, int K, int N, bf16* WT, int dst_row0, int src_col0, int k0, const float* kscale, LAS float* scr, int lane) {
    const int kq = lane >> 3, nq = (lane & 7) * 4; f32x4 v[8];
    if (BT1MAP) src_col0 = bt1_src_col(dst_row0 + nq) - nq;
#pragma unroll
    for (int i = 0; i < 8; ++i) v[i] = *(const f32x4*)(W + (size_t)(k0 + 8 * i + kq) * N + src_col0 + nq);
#pragma unroll
    for (int i = 0; i < 8; ++i) { const int kk = 8 * i + kq; const float sc = kscale ? kscale[k0 + kk] : 1.0f;
#pragma unroll
        for (int e = 0; e < 4; ++e) scr[kk * 33 + nq + e] = v[i][e] * sc; }
    asm volatile("s_waitcnt lgkmcnt(0)" ::: "memory");
    const int c = lane & 7;
#pragma unroll
    for (int j = 0; j < 4; ++j) { const int n = (lane >> 3) + 8 * j; const LAS float* sp = scr + (8 * c) * 33 + n;
        v4u o; o.x = pg8::cvt_pk_bf16(sp[0 * 33], sp[1 * 33]); o.y = pg8::cvt_pk_bf16(sp[2 * 33], sp[3 * 33]); o.z = pg8::cvt_pk_bf16(sp[4 * 33], sp[5 * 33]); o.w = pg8::cvt_pk_bf16(sp[6 * 33], sp[7 * 33]);
        *(v4u*)(WT + (size_t)(dst_row0 + n) * K + k0 + 8 * c) = o; }
    asm volatile("s_waitcnt lgkmcnt(0)" ::: "memory");
}
__device__ __forceinline__ int bt1_src_col(int r) {
    if (r < 512) return r;
    if (r >= 4608) return 3584 + (r - 4608);
    const int t = r - 512, q = t >> 8, c = t & 255, bj = c >> 7, wc = (c >> 5) & 3, fq = (c >> 3) & 3, n = (c >> 2) & 1, e = c & 3, T = 2 * bj + n, j = 64 * q + 16 * wc + 4 * fq + e;
    return (T == 0 ? 512 : T == 1 ? 1536 : T == 2 ? 2560 : 4608) + j; }

__global__ void __launch_bounds__(NTHR, 2) fwd_megakernel(Args args) {
    extern __shared__ __attribute__((aligned(16))) unsigned char lds_raw[];
    LAS unsigned char* lds = (LAS unsigned char*)lds_raw;
    const int tid = threadIdx.x, lane = tid & 63, wave = __builtin_amdgcn_readfirstlane(tid >> 6);
    const int G = gridDim.x, bx = blockIdx.x;
    const int vcu = (G % 8 == 0) ? (bx % 8) * (G / 8) + bx / 8 : bx;
    unsigned char* ws = args.ws;
    if (tid < 8) ((LAS unsigned*)(lds + RING_BYTES))[tid] = 0u;
    __syncthreads();
    const XcdBarrier bar = xcd_barrier_post((unsigned*)(ws + WS_BAR), (volatile LAS unsigned*)(lds + RING_BYTES));
    const float* x = args.in[0];
    float* SS2 = (float*)(ws + WS_SS2); float* SS3 = (float*)(ws + WS_SS3); float* BIASP = (float*)(ws + WS_BIAS);
    bf16* BT1 = (bf16*)(ws + WS_BT1); bf16* BT2A = (bf16*)(ws + WS_BT2A); bf16* BT2B = (bf16*)(ws + WS_BT2B); bf16* BT3 = (bf16*)(ws + WS_BT3);
    bf16* BT4 = (bf16*)(ws + WS_BT4); bf16* BT5 = (bf16*)(ws + WS_BT5); bf16* TZ = (bf16*)(ws + WS_TZ); bf16* MS = (bf16*)(ws + WS_MS);
    bf16* XN = (bf16*)(ws + WS_XN); bf16* Z = (bf16*)(ws + WS_Z); float* SLOC = (float*)(ws + WS_SLOC); bf16* HB = (bf16*)(ws + WS_HB);
    bf16* UA = (bf16*)(ws + WS_UA); bf16* CB = (bf16*)(ws + WS_CB); float* HALO = (float*)(ws + WS_HALO); float* CBH = (float*)(ws + WS_CBH); unsigned char* GS8 = ws + WS_GS; unsigned char* GC8 = ws + WS_GC; bf16* YB = (bf16*)(ws + WS_YB); float* RMS = (float*)(ws + WS_RMS); float* GINV = (float*)(ws + WS_GINV);
    bf16* HID = (bf16*)(ws + WS_HID);
    const int lo = args.ph_lo, hi = args.ph_hi;
#define IN(k) (lo <= (k) && (k) < hi)
#define SEAM(k) do { if (IN(k) && IN((k) + 1)) { if ((k) >= 1 && local_ok) xcd_barrier_local(bar); else xcd_barrier(bar); } } while (0)
    const int gw = vcu * NWAVES + wave, NGW = G * NWAVES;
    bool local_ok = false; int c = bx;

    if (IN(0)) {
        for (int task = bx; task < NGRP * 8; task += G) {
            const int gidx = task >> 3, part = task & 7;
            LAS float* L = (LAS float*)lds;
            LAS float* APR = L; LAS float* API = L + 17 * 64; LAS float* BBR = L + 2 * 17 * 64; LAS float* BBI = BBR + 1024; LAS float* CTR = BBI + 1024; LAS float* CTI = CTR + 1024; LAS float* KT = CTI + 1024;
            const float* lam_re = args.in[4] + gidx * 64; const float* lam_im = args.in[5] + gidx * 64; const float dt = expf(args.in[6][gidx]);
            const float* bre = args.in[7] + gidx * 1024; const float* bim = args.in[8] + gidx * 1024; const float* cre = args.in[9] + gidx * 1024; const float* cim = args.in[10] + gidx * 1024;
            __syncthreads();
            if (tid < 64) { const int n = tid; const float lr = lam_re[n], li = lam_im[n];
                const float xm = lr * dt, mag = expf(xm), th = li * dt; const float sn = sinf(th), cs = cosf(th), sh = sinf(0.5f * th);
                const float ar = mag * cs, aim = mag * sn;
                const float er = expm1f(xm) * cs - 2.0f * sh * sh, ei = aim, den = lr * lr + li * li;
                const float qr = (er * lr + ei * li) / den, qi = (ei * lr - er * li) / den;
                float pr = 1.f, pi = 0.f;
                for (int k = 0; k <= 16; ++k) { APR[k * 64 + n] = pr; API[k * 64 + n] = pi; const float t = pr * ar - pi * aim; pi = pr * aim + pi * ar; pr = t; }
                for (int ci = 0; ci < 16; ++ci) { const float br = bre[n * 16 + ci], bi = bim[n * 16 + ci]; BBR[n * 16 + ci] = qr * br - qi * bi; BBI[n * 16 + ci] = qr * bi + qi * br; }
            }
            for (int idx = tid; idx < 1024; idx += NTHR) { const int co = idx >> 6, n = idx & 63; CTR[n * 16 + co] = cre[idx]; CTI[n * 16 + co] = cim[idx]; }
            __syncthreads();
            for (int idx = tid; idx < 4096; idx += NTHR) { const int k = idx >> 8, co = (idx >> 4) & 15, ci = idx & 15; float s = 0.f;
                for (int n = 0; n < 64; ++n) { const float cr = CTR[n * 16 + co], cim_ = CTI[n * 16 + co], pr = APR[k * 64 + n], pi = API[k * 64 + n];
                    const float wre = cr * pr - cim_ * pi, wim = cr * pi + cim_ * pr; s += wre * BBR[n * 16 + ci] - wim * BBI[n * 16 + ci]; }
                if (k == 0 && co == ci) s += args.in[11][gidx * 16 + co];
                KT[idx] = s; }
            __syncthreads();
            for (int id = tid; id < 32 * 48; id += NTHR) { const int rr = id / 48, c8 = id % 48, j = part * 2 + (rr >> 4), co = rr & 15; float v[8];
                if (c8 < 32) { const int i = c8 >> 1, ci0 = (c8 & 1) * 8;
#pragma unroll
                    for (int e = 0; e < 8; ++e) v[e] = (i <= j) ? KT[((j - i) & 15) * 256 + co * 16 + ci0 + e] : 0.f;
                } else { const bool im = c8 >= 40; const int n0 = (c8 - (im ? 40 : 32)) * 8;
#pragma unroll
                    for (int e = 0; e < 8; ++e) { const int n = n0 + e; const float cr = CTR[n * 16 + co], cim_ = CTI[n * 16 + co], pr = APR[(j + 1) * 64 + n], pi = API[(j + 1) * 64 + n];
                        v[e] = im ? -(cr * pi + cim_ * pr) : (cr * pr - cim_ * pi); } }
                v4u o; o.x = pg8::cvt_pk_bf16(v[0], v[1]); o.y = pg8::cvt_pk_bf16(v[2], v[3]); o.z = pg8::cvt_pk_bf16(v[4], v[5]); o.w = pg8::cvt_pk_bf16(v[6], v[7]);
                *(v4u*)(TZ + ((size_t)(gidx * 256 + part * 32 + rr)) * UAK + c8 * 8) = o; }
            { const int rr = tid >> 5, c8 = tid & 31, rho = part * 16 + rr, im = rho >> 6, n = rho & 63, i = c8 >> 1, ci0 = (c8 & 1) * 8; float v[8];
                const float pr = APR[(15 - i) * 64 + n], pi = API[(15 - i) * 64 + n];
#pragma unroll
                for (int e = 0; e < 8; ++e) { const float br = BBR[n * 16 + ci0 + e], bi = BBI[n * 16 + ci0 + e]; v[e] = im ? (pr * bi + pi * br) : (pr * br - pi * bi); }
                v4u o; o.x = pg8::cvt_pk_bf16(v[0], v[1]); o.y = pg8::cvt_pk_bf16(v[2], v[3]); o.z = pg8::cvt_pk_bf16(v[4], v[5]); o.w = pg8::cvt_pk_bf16(v[6], v[7]);
                *(v4u*)(MS + ((size_t)(gidx * 128 + rho)) * 256 + c8 * 8) = o; }
            __syncthreads();
        }
        for (int i = bx * NTHR + tid; i < 128 * 256 / 8; i += G * NTHR) *(v4u*)(MS + (size_t)4096 * 256 + (size_t)i * 8) = (v4u){0u, 0u, 0u, 0u};
        for (int i = bx * NTHR + tid; i < NIN; i += G * NTHR) BIASP[i] = args.in[3][bt1_src_col(i)];
        for (int i = bx * NTHR + tid; i < D; i += G * NTHR) GINV[i] = 1.0f / args.in[1][i];
        __syncthreads();
        {
            LAS float* scr = (LAS float*)(lds + wave * 16384);
            constexpr int I1 = (D / 64) * (NIN / 32), I2A = (SSMW / 64) * (2048 / 32), I2B = (D / 64) * (D / 32), I3 = I2B, I4 = (D / 64) * (FF / 32), I5 = (FF / 64) * (D / 32);
#define P0_LOOP(base, cnt) for (int r = ((gw - (base)) % NGW + NGW) % NGW; r < (cnt); r += NGW)
            P0_LOOP(0, I1) { const int nblk = NIN / 32, kb = r / nblk, nb = r % nblk; p0_transpose_item<true>(args.in[2], D, NIN, BT1, nb * 32, 0, kb * 64, nullptr, scr, lane); }
            P0_LOOP(I1, I2A) { const int nblk = 2048 / 32, kb = r / nblk, nb = r % nblk, row0 = nb * 32, t = row0 >> 8, half = (row0 >> 7) & 1, j = row0 & 127;
                if (half) p0_transpose_item(args.in[13], SSMW, D, BT2A, row0, t * 128 + j, kb * 64, nullptr, scr, lane);
                else p0_transpose_item(args.in[12], SSMW, D, BT2A, row0, t * 128 + j, kb * 64, nullptr, scr, lane); }
            P0_LOOP(I1 + I2A, I2B) { const int nblk = D / 32, kb = r / nblk, nb = r % nblk; p0_transpose_item(args.in[16], D, D, BT2B, nb * 32, nb * 32, kb * 64, nullptr, scr, lane); }
            P0_LOOP(I1 + I2A + I2B, I3) { const int nblk = D / 32, kb = r / nblk, nb = r % nblk; p0_transpose_item(args.in[17], D, D, BT3, nb * 32, nb * 32, kb * 64, nullptr, scr, lane); }
            P0_LOOP(I1 + I2A + I2B + I3, I4) { const int nblk = FF / 32, kb = r / nblk, nb = r % nblk; p0_transpose_item(args.in[19], D, FF, BT4, nb * 32, nb * 32, kb * 64, args.in[18], scr, lane); }
            P0_LOOP(I1 + I2A + I2B + I3 + I4, I5) { const int nblk = D / 32, kb = r / nblk, nb = r % nblk; p0_transpose_item(args.in[20], FF, D, BT5, nb * 32, nb * 32, kb * 64, nullptr, scr, lane); }
#undef P0_LOOP
        }
        {
            const f32x4* g4 = (const f32x4*)args.in[1] + 2 * lane; f32x4 gv[2][2];
#pragma unroll
            for (int j = 0; j < 2; ++j) { gv[j][0] = g4[128 * j]; gv[j][1] = g4[128 * j + 1]; }
            for (int m0 = gw * 4; m0 < M; m0 += NGW * 4) {
                f32x4 v[4][2][2]; float s[4];
#pragma unroll
                for (int r = 0; r < 4; ++r) { const f32x4* xr = (const f32x4*)(x + (size_t)(m0 + r) * D) + 2 * lane;
#pragma unroll
                    for (int j = 0; j < 2; ++j) { v[r][j][0] = xr[128 * j]; v[r][j][1] = xr[128 * j + 1]; } }
#pragma unroll
                for (int r = 0; r < 4; ++r) { f32x4 q = v[r][0][0] * v[r][0][0] + v[r][0][1] * v[r][0][1] + v[r][1][0] * v[r][1][0] + v[r][1][1] * v[r][1][1]; s[r] = (q[0] + q[1]) + (q[2] + q[3]); }
#pragma unroll
                for (int o = 1; o < 64; o <<= 1) {
#pragma unroll
                    for (int r = 0; r < 4; ++r) s[r] += __shfl_xor(s[r], o); }
#pragma unroll
                for (int r = 0; r < 4; ++r) { const float rms = sqrtf(s[r] * (1.0f / D) + EPS), ri = 1.0f / rms; if (lane == 0) RMS[m0 + r] = rms; u32x4* o16 = (u32x4*)(XN + (size_t)(m0 + r) * D) + lane;
#pragma unroll
                    for (int j = 0; j < 2; ++j) o16[64 * j] = pg8::pack8(v[r][j][0] * ri * gv[j][0], v[r][j][1] * ri * gv[j][1]); }
            }
        }
    }
    SEAM(0);
    if (lo == 0 && hi == 8) { volatile LAS unsigned* st = (volatile LAS unsigned*)(lds + RING_BYTES);
        const unsigned uni = (unsigned)__builtin_amdgcn_readfirstlane((int)st[4]), xcc = (unsigned)__builtin_amdgcn_readfirstlane((int)st[2]), rk = (unsigned)__builtin_amdgcn_readfirstlane((int)st[3]);
        if (uni && xcc < 8u && rk < 32u) { local_ok = true; c = (int)(rk * 8u + xcc); } }
    const int cx = c & 7, cr = c >> 3;

    if (IN(1)) {
        pg8::Gemm g{ws, (unsigned)WS_XN, (unsigned)WS_BT1, D, D, D}; pg8::StaticOrder S; S.init(M, NIN, G, c);
        EpiG1 E{UA, CB, GS8, GC8, BIASP, args.in[14], args.in[15], HALO, CBH};
        pg8::gemm_phase<EpiG1, pg8::StaticOrder>(lds, g, S, E);
    }
    SEAM(1);

    if (IN(2)) {
        { pg8::Gemm g{ws, (unsigned)WS_UA, (unsigned)WS_MS, UAK, 256, 256}; pg8::GroupOrder S{512, G, c, 128}; EpiS1 E{SLOC};
          pg8::gemm_phase<EpiS1, pg8::GroupOrder>(lds, g, S, E); }
        asm volatile("s_waitcnt vmcnt(0)" ::: "memory"); __syncthreads();
        if (tid < 256) { const int L = cr * 16 + 2 * cx + (tid >> 7);
            const int n = tid & 63, b = 2 * (L & 15) + ((tid >> 6) & 1), gidx = L >> 4;
            const float lr = args.in[4][gidx * 64 + n], li = args.in[5][gidx * 64 + n], dt = expf(args.in[6][gidx]);
            const float mag = expf(lr * dt * 16.0f), th = li * dt; float ar = cosf(th), ai = sinf(th);
#pragma unroll
            for (int q = 0; q < 4; ++q) { const float t = ar * ar - ai * ai; ai = 2.0f * ar * ai; ar = t; }
            ar *= mag; ai *= mag;
            const float* sl = SLOC + ((size_t)gidx * BCROWS + b * NCHUNK) * 128 + n; bf16* ua = UA + ((size_t)gidx * BCROWS + b * NCHUNK) * UAK + 256 + n;
            float sr = 0.f, si = 0.f;
            for (int c0 = 0; c0 < NCHUNK; c0 += 8) { float lre[8], lim[8];
#pragma unroll
                for (int q = 0; q < 8; ++q) { lre[q] = sl[(size_t)(c0 + q) * 128]; lim[q] = sl[(size_t)(c0 + q) * 128 + 64]; }
#pragma unroll
                for (int q = 0; q < 8; ++q) { ua[(size_t)(c0 + q) * UAK] = (bf16)(pg8::cvt_pk_bf16(sr, 0.f) & 0xffffu); ua[(size_t)(c0 + q) * UAK + 64] = (bf16)(pg8::cvt_pk_bf16(si, 0.f) & 0xffffu);
                    const float t = ar * sr - ai * si + lre[q]; si = ar * si + ai * sr + lim[q]; sr = t; } }
        }
        asm volatile("s_waitcnt vmcnt(0)" ::: "memory"); __syncthreads();
        { pg8::Gemm g{ws, (unsigned)WS_UA, (unsigned)WS_TZ, UAK, UAK, UAK}; pg8::GroupOrder S{512, G, c, 256}; EpiS3 E{Z};
          pg8::gemm_phase<EpiS3, pg8::GroupOrder>(lds, g, S, E); }
        {
            const float* cw = args.in[14];
            const int it = cr * NTHR + tid, hb = 64 * cx + (it >> 8), c4 = (it & 255) * 4;
            if (((hb * 128) & (SEQ - 1)) != 0) {
                const f32x4 m2 = *(const f32x4*)(HALO + ((size_t)(hb - 1) * 2 + 0) * D + c4), m1 = *(const f32x4*)(HALO + ((size_t)(hb - 1) * 2 + 1) * D + c4);
                const f32x4 c0 = *(const f32x4*)(CBH + ((size_t)hb * 2 + 0) * D + c4), c1 = *(const f32x4*)(CBH + ((size_t)hb * 2 + 1) * D + c4);
                const f32x4 w0 = *(const f32x4*)(cw + c4), w1 = *(const f32x4*)(cw + D + c4);
                bf16* r0 = CB + (size_t)hb * 128 * D + c4; bf16* r1 = r0 + D;
                const pg8::u32x2 a0 = *(const pg8::u32x2*)r0, a1 = *(const pg8::u32x2*)r1;
                const f32x4 v0 = (f32x4){pg8::bf_lo(a0.x), pg8::bf_hi(a0.x), pg8::bf_lo(a0.y), pg8::bf_hi(a0.y)} + c0 * (w0 * m2 + w1 * m1);
                const f32x4 v1 = (f32x4){pg8::bf_lo(a1.x), pg8::bf_hi(a1.x), pg8::bf_lo(a1.y), pg8::bf_hi(a1.y)} + c1 * (w0 * m1);
                pg8::u32x2 o0, o1; o0.x = pg8::cvt_pk_bf16(v0[0], v0[1]); o0.y = pg8::cvt_pk_bf16(v0[2], v0[3]); o1.x = pg8::cvt_pk_bf16(v1[0], v1[1]); o1.y = pg8::cvt_pk_bf16(v1[2], v1[3]);
                *(pg8::u32x2*)r0 = o0; *(pg8::u32x2*)r1 = o1; }
        }
    }
    SEAM(2);

    if (IN(3)) {
        pg8::G2Order S; S.base.init(M, D, G, c);
        EpiG2ab E{EpiG2b{GC8, YB}, EpiG2a{GS8, YB, YB}};
        pg8::gemm_phase_multi<EpiG2ab, pg8::G2Order>(lds, ws, (unsigned)WS_CB, (unsigned)WS_BT2B, (unsigned)WS_Z, (unsigned)WS_BT2A, S, E);
    }
    SEAM(3);

    if (IN(4)) {
        pg8::Gemm g{ws, (unsigned)WS_YB, (unsigned)WS_BT3, D, D, D}; pg8::StaticOrder S; S.init(M, D, G, c);
        LAS float* RMSL = (LAS float*)(lds + RING_BYTES + 256);
        { Unit u; for (int i = 0; i < 16 && S.next(i, u); ++i) if (tid < 256) RMSL[i * 256 + tid] = RMS[(size_t)u.pm * BM + tid];
          __syncthreads(); }
        EpiRes6 E{XN, GINV, RMSL, SS2};
        pg8::gemm_phase<EpiRes6, pg8::StaticOrder>(lds, g, S, E);
    }
    SEAM(4);

    if (IN(5)) {
        pg8::Gemm g{ws, (unsigned)WS_HB, (unsigned)WS_BT4, D, D, D}; pg8::StaticOrder S; S.init(M, FF, G, c);
        LAS float* RI2 = (LAS float*)(lds + RING_BYTES + 256);
        { Unit u; const int r = tid >> 1, hf = tid & 1;
          for (int i = 0; i < 16 && S.next(i, u); ++i) { const float* sp = SS2 + ((size_t)u.pm * BM + r) * 16 + hf * 8; const f32x4 a = *(const f32x4*)sp, b = *(const f32x4*)(sp + 4);
              float sm = ((a[0] + a[1]) + (a[2] + a[3])) + ((b[0] + b[1]) + (b[2] + b[3])); sm += __shfl_xor(sm, 1);
              if (hf == 0) RI2[i * 256 + r] = 1.0f / (sm * (1.0f / D) + EPS); }
          __syncthreads(); }
        EpiG4 E{HID, RI2};
        pg8::gemm_phase<EpiG4, pg8::StaticOrder>(lds, g, S, E);
    }
    SEAM(5);

    if (IN(6)) {
        pg8::Gemm g{ws, (unsigned)WS_HID, (unsigned)WS_BT5, FF, FF, FF}; pg8::StaticOrder S; S.init(M, D, G, c); EpiRes8 E{HB, SS3};
        pg8::gemm_phase<EpiRes8, pg8::StaticOrder>(lds, g, S, E);
    }
    SEAM(6);

    if (IN(7)) {
        const f32x4* g4 = (const f32x4*)args.in[21] + 2 * lane; f32x4 gv[2][2];
#pragma unroll
        for (int j = 0; j < 2; ++j) { gv[j][0] = g4[128 * j]; gv[j][1] = g4[128 * j + 1]; }
        for (int m = 8192 * cx + cr * NWAVES + wave; m < 8192 * (cx + 1); m += 32 * NWAVES) {
            float s = (lane < 16) ? SS3[(size_t)m * 16 + lane] : 0.f; s = wave_sum(s);
            const float ri = 1.0f / sqrtf(s * (1.0f / D) + EPS);
            const u32x4* hrow = (const u32x4*)(HB + (size_t)m * D) + lane; f32x4* orow = (f32x4*)(args.out + (size_t)m * D) + 2 * lane;
#pragma unroll
            for (int j = 0; j < 2; ++j) { f32x4 h0, h1; pg8::unpack8(hrow[64 * j], h0, h1); orow[128 * j] = h0 * ri * gv[j][0]; orow[128 * j + 1] = h1 * ri * gv[j][1]; }
        }
    }
#undef IN
#undef SEAM
}

extern "C" void kernel_launch(void* const* d_in, const int* in_sizes, int n_in, void* d_out, int out_size, void* d_ws, size_t ws_size, hipStream_t stream) {
    static int grid = 0;
    if (grid == 0) {
        if (n_in != 22 || in_sizes[0] != M * D || out_size != M * D || ws_size < WS_END) { fprintf(stderr, "kernel_launch: unexpected shapes: n_in %d in0 %d out %d ws %zu (need %zu)\n", n_in, n_in > 0 ? in_sizes[0] : -1, out_size, ws_size, (size_t)WS_END); grid = -1; return; }
        int dev = 0, cus = 0, per_cu = 0;
        if (hipGetDevice(&dev) != hipSuccess || hipDeviceGetAttribute(&cus, hipDeviceAttributeMultiprocessorCount, dev) != hipSuccess) { fprintf(stderr, "kernel_launch: device query failed\n"); grid = -1; return; }
        if (hipFuncSetAttribute((const void*)fwd_megakernel, hipFuncAttributeMaxDynamicSharedMemorySize, LDS_BYTES) != hipSuccess) { fprintf(stderr, "kernel_launch: hipFuncSetAttribute failed\n"); grid = -1; return; }
        if (hipOccupancyMaxActiveBlocksPerMultiprocessor(&per_cu, (const void*)fwd_megakernel, NTHR, LDS_BYTES) != hipSuccess || per_cu < 1) { fprintf(stderr, "kernel_launch: occupancy query says %d blocks per CU\n", per_cu); (void)hipGetLastError(); grid = -1; return; }
        if (cus != 256) { fprintf(stderr, "kernel_launch: built for a 256-CU device (unit dealing assumes 256 workgroups); found %d CUs\n", cus); grid = -1; return; }
        grid = cus;
    }
    if (grid < 0) return;
    if (hipMemsetAsync((char*)d_ws + WS_BAR, 0, 32768, stream) != hipSuccess) { fprintf(stderr, "kernel_launch: memset of the barrier words failed\n"); return; }
    Args a{};
    for (int i = 0; i < 22; ++i) a.in[i] = (const float*)d_in[i];
    a.out = (float*)d_out; a.ws = (unsigned char*)d_ws;
#if MK_PER_PHASE
    for (int p = 0; p < 8; ++p) { a.ph_lo = p; a.ph_hi = p + 1; void* kargs[] = {&a};
        hipError_t e = hipLaunchCooperativeKernel((const void*)fwd_megakernel, dim3(grid), dim3(NTHR), kargs, LDS_BYTES, stream);
        if (e != hipSuccess) { fprintf(stderr, "kernel_launch: phase %d launch failed: %s\n", p, hipGetErrorString(e)); break; } }
#else
    a.ph_lo = 0; a.ph_hi = 8; void* kargs[] = {&a};
    hipError_t e = hipLaunchCooperativeKernel((const void*)fwd_megakernel, dim3(grid), dim3(NTHR), kargs, LDS_BYTES, stream);
    if (e != hipSuccess) fprintf(stderr, "kernel_launch: cooperative launch failed: %s (grid %d)\n", hipGetErrorString(e), grid);
#endif
}
```

```cpp
#include <hip/hip_runtime.h>
#include <cstdio>
#include <cstdint>

#ifndef XCC_STAGGER_TICKS
#define XCC_STAGGER_TICKS 0
#endif
#ifndef MK_PER_PHASE
#define MK_PER_PHASE 0
#endif

namespace pg8 {
#define PG8_LAS __attribute__((address_space(3)))
typedef unsigned short bf16_t;
typedef short bf16x8 __attribute__((ext_vector_type(8)));
typedef float f32x4 __attribute__((ext_vector_type(4)));
typedef unsigned u32x4 __attribute__((ext_vector_type(4)));
typedef unsigned u32x2 __attribute__((ext_vector_type(2)));
typedef int i32x4 __attribute__((ext_vector_type(4)));
#define FP8_WSCALE 0x79797979
#define FP8_WMUL 64.0f
constexpr int BM = 256, BK = 64, HALF = 128, HTB = HALF * BK * 2  , STAGE_BYTES = 8 * HTB, NXCD = 8, WGM = 8;

__host__ __device__ __forceinline__ int lds_byte(int r, int c) { return r * 128 + ((((c >> 3) ^ (r >> 1)) & 7) << 4) + (c & 7) * 2; }
__host__ __device__ __forceinline__ void stage_rc(int b, int& R, int& C) { R = b >> 7; C = ((((b >> 4) ^ (R >> 1)) & 7)) * 8; }
__host__ __device__ __forceinline__ int perm32(int rho) { const int n = rho >> 4, i = rho & 15; return 8 * (i >> 2) + 4 * n + (i & 3); }

struct Unit { int pm, pn, kind; };
struct Gemm { const unsigned char* ws; unsigned Aoff, Boff; int lda, ldb, K; };
#define PG8_RSRC(base) __builtin_amdgcn_make_buffer_rsrc((void*)(base), 0, 0x7fffffff, 0x00020000)

struct StaticOrder {
    int nM, nN, nwg, G, c;
    __device__ void init(int M, int N, int G_, int c_) { nM = M / BM; nN = N / BM; nwg = nM * nN; G = G_; c = c_; }
    __device__ bool next(int i, Unit& u) const {
        const long L = (long)i * G + c; if (L >= nwg) return false;
        int wgid = (int)L; { const int q = nwg / NXCD, r = nwg % NXCD, xcd = wgid % NXCD, off = wgid / NXCD; wgid = (xcd < r ? xcd * (q + 1) : r * (q + 1) + (xcd - r) * q) + off; }
        const int nig = WGM * nN, gid = wgid / nig, fm = gid * WGM, gsz = (nM - fm) < WGM ? (nM - fm) : WGM;
        u.pm = fm + ((wgid % nig) % gsz); u.pn = (wgid % nig) / gsz; u.kind = 0; return true;
    }
    __device__ __forceinline__ size_t arow(const Unit& u) const { return (size_t)u.pm * BM; }
    __device__ __forceinline__ size_t brow(const Unit& u) const { return (size_t)u.pn * BM; }
};
struct GroupOrder {
    int nunits, G, c, brows;
    __device__ bool next(int i, Unit& u) const { if (i >= 2 || G != 256) return false; u.pm = (c >> 3) * 16 + 2 * (c & 7) + i; u.pn = 0; u.kind = 0; return true; }
    __device__ __forceinline__ size_t arow(const Unit& u) const { return (size_t)u.pm * BM; }
    __device__ __forceinline__ size_t brow(const Unit& u) const { return (size_t)(u.pm >> 4) * brows; }
};

__device__ __forceinline__ unsigned cvt_pk_bf16(float lo, float hi) { unsigned r; asm volatile("v_cvt_pk_bf16_f32 %0, %1, %2" : "=v"(r) : "v"(lo), "v"(hi)); return r; }
__device__ __forceinline__ float bf_lo(unsigned w) { return __uint_as_float(w << 16); }
__device__ __forceinline__ float bf_hi(unsigned w) { return __uint_as_float(w & 0xffff0000u); }
__device__ __forceinline__ float relu_f(float x) { float r; asm("v_max_f32 %0, 0, %1" : "=v"(r) : "v"(x)); return r; }
__device__ __forceinline__ float sigmoid_f(float x) { return __builtin_amdgcn_rcpf(1.0f + __builtin_amdgcn_exp2f(-1.4426950409f * x)); }
__device__ __forceinline__ unsigned sig255_pk(const f32x4& t) {
    const f32x4 e = {__builtin_amdgcn_exp2f(t[0]), __builtin_amdgcn_exp2f(t[1]), __builtin_amdgcn_exp2f(t[2]), __builtin_amdgcn_exp2f(t[3])};
    const f32x4 u = e * (1.0f / 255.0f) + (1.0f / 255.0f); unsigned w = 0u;
#pragma unroll
    for (int i = 0; i < 4; ++i) w = __builtin_amdgcn_cvt_pk_u8_f32(__builtin_rintf(__builtin_amdgcn_rcpf(u[i])), i, w);
    return w; }
__device__ __forceinline__ float gelu_tanh_f(float x) { const float z = x * (1.0f + 0.044715f * x * x); return x * __builtin_amdgcn_rcpf(1.0f + __builtin_amdgcn_exp2f(-2.3022081981f * z)); }
__device__ __forceinline__ u32x4 pack8(const f32x4& a, const f32x4& b) { u32x4 w; w.x = cvt_pk_bf16(a[0], a[1]); w.y = cvt_pk_bf16(a[2], a[3]); w.z = cvt_pk_bf16(b[0], b[1]); w.w = cvt_pk_bf16(b[2], b[3]); return w; }
__device__ __forceinline__ void unpack8(const u32x4& w, f32x4& a, f32x4& b) { a = (f32x4){bf_lo(w.x), bf_hi(w.x), bf_lo(w.y), bf_hi(w.y)}; b = (f32x4){bf_lo(w.z), bf_hi(w.z), bf_lo(w.w), bf_hi(w.w)}; }

template <class Epi, class Sched>
__device__ __forceinline__ void gemm_phase(PG8_LAS unsigned char* lds, const Gemm g, const Sched& S, const Epi& E) {
    const int tid = threadIdx.x, wid = __builtin_amdgcn_readfirstlane(tid >> 6), lane = tid & 63, wr = wid >> 2, wc = wid & 3, fr = lane & 15, fq = lane >> 4;
    const int nt = g.K / BK;
    unsigned voffA[2], voffB[2];
#pragma unroll
    for (int i = 0; i < 2; ++i) { int R, C; stage_rc(tid * 16 + i * 8192, R, C); const int Rb = Epi::PERM ? ((R & ~31) + perm32(R & 31)) : R;
        const int Ra = Epi::ROWPERM ? (128 * (R >> 6) + 8 * (R & 15) + ((R >> 4) & 3)) : R;
        voffA[i] = (unsigned)(Ra * g.lda + C) * 2u; voffB[i] = (unsigned)(Rb * g.ldb + C) * 2u; }
    const __amdgpu_buffer_rsrc_t rs = PG8_RSRC(g.ws);
    const unsigned kstep = (unsigned)(BK * 2);
    const unsigned hstepA = (unsigned)(Epi::ROWPERM ? 4 : HALF) * g.lda * 2, hstepB = (unsigned)HALF * g.ldb * 2;
    const unsigned ldsw = (unsigned)wid * 1024u;
    const int aoff0 = lds_byte(wr * 64 + fr, fq * 8), aoff1 = lds_byte(wr * 64 + fr, fq * 8 + 32), boff0 = lds_byte(wc * 32 + fr, fq * 8), boff1 = lds_byte(wc * 32 + fr, fq * 8 + 32);
#define PG8_SA(b, h) (((b) * 2 + (h)) * HTB)
#define PG8_SB(b, h) ((4 + (b) * 2 + (h)) * HTB)
#define PG8_STAGE(bufoff, soff, voff) do { _Pragma("unroll") for (int _i = 0; _i < 2; ++_i) \
        __builtin_amdgcn_raw_ptr_buffer_load_lds(rs, (PG8_LAS void*)(lds + (bufoff) + ldsw + _i * 8192), 16, (voff)[_i], (soff), 0, 0); } while (0)
#define PG8_LDA(dst, b, h) do { _Pragma("unroll") for (int m = 0; m < 4; ++m) _Pragma("unroll") for (int k = 0; k < 2; ++k) dst[m][k] = *(const PG8_LAS bf16x8*)(lds + PG8_SA(b, h) + (k ? aoff1 : aoff0) + m * 2048); } while (0)
#define PG8_LDB(dst, b, h) do { _Pragma("unroll") for (int n = 0; n < 2; ++n) _Pragma("unroll") for (int k = 0; k < 2; ++k) dst[n][k] = *(const PG8_LAS bf16x8*)(lds + PG8_SB(b, h) + (k ? boff1 : boff0) + n * 2048); } while (0)
#define PG8_CAT8(x) __builtin_shufflevector(__builtin_bit_cast(i32x4, (x)[0]), __builtin_bit_cast(i32x4, (x)[1]), 0, 1, 2, 3, 4, 5, 6, 7)
#define PG8_Z4 ((f32x4){0.f, 0.f, 0.f, 0.f})
#define PG8_MMA(ai, bj, At, Bt, Z) do { __builtin_amdgcn_s_setprio(1); \
        if constexpr (Epi::FP8) { _Pragma("unroll") for (int m = 0; m < 4; ++m) _Pragma("unroll") for (int n = 0; n < 2; ++n) \
            acc[ai][bj][m][n] = __builtin_amdgcn_mfma_scale_f32_16x16x128_f8f6f4(PG8_CAT8(Bt[n]), PG8_CAT8(At[m]), acc[ai][bj][m][n], 0, 0, 0, FP8_WSCALE, 0, 0x7f7f7f7f); } \
        else { _Pragma("unroll") for (int m = 0; m < 4; ++m) _Pragma("unroll") for (int n = 0; n < 2; ++n) _Pragma("unroll") for (int k = 0; k < 2; ++k) \
            { if ((Z) && k == 0) asm volatile("v_mfma_f32_16x16x32_bf16 %0, %1, %2, 0" : "+v"(acc[ai][bj][m][n]) : "v"(Bt[n][k]), "v"(At[m][k])); else acc[ai][bj][m][n] = __builtin_amdgcn_mfma_f32_16x16x32_bf16(Bt[n][k], At[m][k], acc[ai][bj][m][n], 0, 0, 0); } } \
        __builtin_amdgcn_s_setprio(0); } while (0)
#define PG8_MMA2(ai, At, first) do { if (first) { PG8_MMA(ai, 0, At, B0, 1); PG8_MMA(ai, 1, At, B1, 1); } else { PG8_MMA(ai, 0, At, B0, 0); PG8_MMA(ai, 1, At, B1, 0); } } while (0)
#define PG8_WAIT_V(n) asm volatile("s_waitcnt vmcnt(" #n ")" ::: "memory")
#define PG8_WAIT_VR() asm volatile("s_waitcnt vmcnt(%0)" :: "i"(8 + Epi::NST) : "memory")
#define PG8_WAIT_VN(k) asm volatile("s_waitcnt vmcnt(%0)" :: "i"(Epi::NST + (k)) : "memory")
#define PG8_WAIT_L(n) asm volatile("s_waitcnt lgkmcnt(" #n ")" ::: "memory")
#define PG8_BAR __builtin_amdgcn_s_barrier()
#define PG8_SCHED __builtin_amdgcn_sched_barrier(0)
    Unit cur, nxt; int ui = 0;
    if (!S.next(0, cur)) return;
    f32x4 acc[2][2][4][2];
    _Pragma("unroll") for (int a = 0; a < 2; ++a) _Pragma("unroll") for (int b = 0; b < 2; ++b) _Pragma("unroll") for (int m = 0; m < 4; ++m) _Pragma("unroll") for (int n = 0; n < 2; ++n) asm volatile("" : "=v"(acc[a][b][m][n]));
    constexpr int ZC = Epi::FP8 ? 0 : 1;
    if constexpr (!ZC) { _Pragma("unroll") for (int a = 0; a < 2; ++a) _Pragma("unroll") for (int b = 0; b < 2; ++b) _Pragma("unroll") for (int m = 0; m < 4; ++m) _Pragma("unroll") for (int n = 0; n < 2; ++n) acc[a][b][m][n] = (f32x4){0.f, 0.f, 0.f, 0.f}; }
    bf16x8 At[4][2], B0[2][2], B1[2][2];
    unsigned cA = g.Aoff + (unsigned)(S.arow(cur) * (size_t)g.lda * 2), cB = g.Boff + (unsigned)(S.brow(cur) * (size_t)g.ldb * 2);
    PG8_STAGE(PG8_SB(0, 0), cB, voffB); PG8_STAGE(PG8_SB(0, 1), cB + hstepB, voffB); PG8_STAGE(PG8_SA(0, 0), cA, voffA); PG8_STAGE(PG8_SA(0, 1), cA + hstepA, voffA);
    if (wr == 1) PG8_BAR;
    PG8_WAIT_V(2); PG8_BAR;
    PG8_STAGE(PG8_SB(1, 0), cB + kstep, voffB); PG8_STAGE(PG8_SA(1, 0), cA + kstep, voffA); PG8_STAGE(PG8_SB(1, 1), cB + hstepB + kstep, voffB);
    PG8_WAIT_V(6); PG8_BAR;
    for (;;) {
        bool has_next; unsigned nA, nB;
#define PG8_NEXT() do { has_next = S.next(ui + 1, nxt); nA = has_next ? g.Aoff + (unsigned)(S.arow(nxt) * (size_t)g.lda * 2) : cA; nB = has_next ? g.Boff + (unsigned)(S.brow(nxt) * (size_t)g.ldb * 2) : cB; } while (0)
#define PG8_BODY(t, FIRST) { \
            const bool last = (FIRST) ? false : (t == nt - 2); \
            const bool relax = (t == 0) && (ui > 0); \
            const unsigned a1 = cA + (unsigned)(t + 1) * kstep; \
            const unsigned a2 = last ? nA : cA + (unsigned)(t + 2) * kstep, b2 = last ? nB : cB + (unsigned)(t + 2) * kstep; \
            const unsigned a3 = a2 + kstep, b3 = b2 + kstep; \
            PG8_LDB(B0, 0, 0); PG8_LDB(B1, 0, 1); PG8_SCHED; PG8_LDA(At, 0, 0); if (!(FIRST) || ui == 0) PG8_STAGE(PG8_SA(1, 1), a1 + hstepA, voffA); \
            if ((FIRST) && ui > 0) PG8_WAIT_VN(0); else if ((t == 0) && relax) PG8_WAIT_VR(); else PG8_WAIT_V(8); \
            PG8_WAIT_L(0); PG8_BAR; PG8_MMA(0, 0, At, B0, FIRST); PG8_MMA(0, 1, At, B1, FIRST); PG8_BAR; PG8_SCHED; \
            PG8_LDA(At, 0, 1); PG8_STAGE(PG8_SB(0, 0), b2, voffB); PG8_STAGE(PG8_SB(0, 1), b2 + hstepB, voffB); PG8_STAGE(PG8_SA(0, 0), a2, voffA); \
            if ((FIRST) && ui > 0) PG8_WAIT_VN(6); else if ((t == 0) && relax) PG8_WAIT_VR(); else PG8_WAIT_V(8); \
            PG8_WAIT_L(0); PG8_BAR; PG8_MMA(1, 0, At, B0, FIRST); PG8_MMA(1, 1, At, B1, FIRST); PG8_BAR; PG8_SCHED; \
            PG8_LDB(B0, 1, 0); PG8_LDB(B1, 1, 1); PG8_SCHED; PG8_LDA(At, 1, 0); PG8_STAGE(PG8_SA(0, 1), a2 + hstepA, voffA); \
            if ((FIRST) && ui > 0) PG8_WAIT_VN(8); else PG8_WAIT_V(8); \
            PG8_WAIT_L(0); PG8_BAR; PG8_MMA(0, 0, At, B0, 0); PG8_MMA(0, 1, At, B1, 0); PG8_BAR; PG8_SCHED; \
            PG8_LDA(At, 1, 1); PG8_STAGE(PG8_SB(1, 0), b3, voffB); PG8_STAGE(PG8_SB(1, 1), b3 + hstepB, voffB); PG8_STAGE(PG8_SA(1, 0), a3, voffA); \
            if ((FIRST) && ui > 0) PG8_WAIT_VN(14); else PG8_WAIT_V(8); \
            PG8_WAIT_L(0); PG8_BAR; PG8_MMA(1, 0, At, B0, 0); PG8_MMA(1, 1, At, B1, 0); PG8_BAR; PG8_SCHED; }
        if constexpr (ZC) { PG8_BODY(0, 1)
            PG8_NEXT();
#pragma unroll 1
            for (int t = 2; t < nt; t += 2) PG8_BODY(t, 0)
        } else { PG8_NEXT();
#pragma unroll 1
            for (int t = 0; t < nt; t += 2) PG8_BODY(t, 0)
        }
#undef PG8_NEXT
#undef PG8_BODY
        if (wr == 0) PG8_BAR;
        if constexpr (ZC) PG8_STAGE(PG8_SA(1, 1), nA + kstep + hstepA, voffA);
        E(acc, cur, ui, wr, wc, fr, fq);
        if (!has_next) break;
        if constexpr (!ZC) { _Pragma("unroll") for (int a = 0; a < 2; ++a) _Pragma("unroll") for (int b = 0; b < 2; ++b) _Pragma("unroll") for (int m = 0; m < 4; ++m) _Pragma("unroll") for (int n = 0; n < 2; ++n) acc[a][b][m][n] = (f32x4){0.f, 0.f, 0.f, 0.f}; }
        cur = nxt; cA = nA; cB = nB; ++ui;
        if (wr == 1) PG8_BAR;
    }
    PG8_WAIT_V(0);
    PG8_BAR;
#undef PG8_SA
#undef PG8_SB
#undef PG8_STAGE
#undef PG8_LDA
#undef PG8_LDB
#undef PG8_MMA
#undef PG8_MMA2
#undef PG8_Z4
#undef PG8_CAT8
#undef PG8_WAIT_V
#undef PG8_WAIT_VR
#undef PG8_WAIT_VN
#undef PG8_WAIT_L
#undef PG8_BAR
#undef PG8_SCHED
}

struct G2Order {
    StaticOrder base;
    __device__ bool next(int i, Unit& u) const { const int tg = i / 3, sub = i - 3 * tg; Unit b; if (!base.next(tg, b)) return false;
        u.pm = b.pm; u.kind = sub ? 1 : 0; u.pn = sub ? 2 * b.pn + sub - 1 : b.pn; return true; }
};
template <class Epi, class Sched>
__device__ __forceinline__ void gemm_phase_multi(PG8_LAS unsigned char* lds, const unsigned char* ws, unsigned gA0, unsigned gB0, unsigned gA1, unsigned gB1, const Sched& S, const Epi& E) {
    const int tid = threadIdx.x, wid = __builtin_amdgcn_readfirstlane(tid >> 6), lane = tid & 63, wr = wid >> 2, wc = wid & 3, fr = lane & 15, fq = lane >> 4;
    unsigned vA[2], vB[2], rA[2], rB[2];
#pragma unroll
    for (int i = 0; i < 2; ++i) { int R, C; stage_rc(tid * 16 + i * 8192, R, C); const int Rb = Epi::PERM ? ((R & ~31) + perm32(R & 31)) : R;
        vA[i] = (unsigned)(R * 1024 + C) * 2u; rA[i] = (unsigned)R * 1024u; vB[i] = (unsigned)(Rb * 1024 + C) * 2u; rB[i] = (unsigned)Rb * 1024u; }
    const __amdgpu_buffer_rsrc_t rs = PG8_RSRC(ws);
    const unsigned kstep = (unsigned)(BK * 2);
    const unsigned ldsw = (unsigned)wid * 1024u;
    const int aoff0 = lds_byte(wr * 64 + fr, fq * 8), aoff1 = lds_byte(wr * 64 + fr, fq * 8 + 32), boff0 = lds_byte(wc * 32 + fr, fq * 8), boff1 = lds_byte(wc * 32 + fr, fq * 8 + 32);
#define PG8_SA(b, h) (((b) * 2 + (h)) * HTB)
#define PG8_SB(b, h) ((4 + (b) * 2 + (h)) * HTB)
#define PG8_STAGE2(bufoff, soff, vX, rX, k) do { _Pragma("unroll") for (int _i = 0; _i < 2; ++_i) \
        __builtin_amdgcn_raw_ptr_buffer_load_lds(rs, (PG8_LAS void*)(lds + (bufoff) + ldsw + _i * 8192), 16, (vX)[_i] - ((k) ? (rX)[_i] : 0u), (soff), 0, 0); } while (0)
#define PG8_LDA(dst, b, h) do { _Pragma("unroll") for (int m = 0; m < 4; ++m) _Pragma("unroll") for (int k = 0; k < 2; ++k) dst[m][k] = *(const PG8_LAS bf16x8*)(lds + PG8_SA(b, h) + (k ? aoff1 : aoff0) + m * 2048); } while (0)
#define PG8_LDB(dst, b, h) do { _Pragma("unroll") for (int n = 0; n < 2; ++n) _Pragma("unroll") for (int k = 0; k < 2; ++k) dst[n][k] = *(const PG8_LAS bf16x8*)(lds + PG8_SB(b, h) + (k ? boff1 : boff0) + n * 2048); } while (0)
#define PG8_Z4 ((f32x4){0.f, 0.f, 0.f, 0.f})
#define PG8_MMA(ai, bj, At, Bt, Z) do { __builtin_amdgcn_s_setprio(1); _Pragma("unroll") for (int m = 0; m < 4; ++m) _Pragma("unroll") for (int n = 0; n < 2; ++n) _Pragma("unroll") for (int k = 0; k < 2; ++k) \
        { if ((Z) && k == 0) asm volatile("v_mfma_f32_16x16x32_bf16 %0, %1, %2, 0" : "+v"(acc[ai][bj][m][n]) : "v"(Bt[n][k]), "v"(At[m][k])); else acc[ai][bj][m][n] = __builtin_amdgcn_mfma_f32_16x16x32_bf16(Bt[n][k], At[m][k], acc[ai][bj][m][n], 0, 0, 0); } __builtin_amdgcn_s_setprio(0); } while (0)
#define PG8_MMA2(ai, At, first) do { if (first) { PG8_MMA(ai, 0, At, B0, 1); PG8_MMA(ai, 1, At, B1, 1); } else { PG8_MMA(ai, 0, At, B0, 0); PG8_MMA(ai, 1, At, B1, 0); } } while (0)
#define PG8_WAIT_V(n) asm volatile("s_waitcnt vmcnt(" #n ")" ::: "memory")
#define PG8_WAIT_VR() asm volatile("s_waitcnt vmcnt(%0)" :: "i"(8 + Epi::NST) : "memory")
#define PG8_WAIT_VN(k) asm volatile("s_waitcnt vmcnt(%0)" :: "i"(Epi::NST + (k)) : "memory")
#define PG8_WAIT_L(n) asm volatile("s_waitcnt lgkmcnt(" #n ")" ::: "memory")
#define PG8_BAR __builtin_amdgcn_s_barrier()
#define PG8_SCHED __builtin_amdgcn_sched_barrier(0)
    Unit cur, nxt; int ui = 0;
    if (!S.next(0, cur)) return;
    f32x4 acc[2][2][4][2];
    _Pragma("unroll") for (int a = 0; a < 2; ++a) _Pragma("unroll") for (int b = 0; b < 2; ++b) _Pragma("unroll") for (int m = 0; m < 4; ++m) _Pragma("unroll") for (int n = 0; n < 2; ++n) asm volatile("" : "=v"(acc[a][b][m][n]));
    bf16x8 At[4][2], B0[2][2], B1[2][2];
    int ck = cur.kind;
    unsigned cA = (ck ? gA1 : gA0) + (((unsigned)cur.pm * BM * 2048u) >> ck), cB = (ck ? gB1 : gB0) + (((unsigned)cur.pn * BM * 2048u) >> ck);
    unsigned hs = (unsigned)(HALF * 2048) >> ck;
    PG8_STAGE2(PG8_SB(0, 0), cB, vB, rB, ck); PG8_STAGE2(PG8_SB(0, 1), cB + hs, vB, rB, ck); PG8_STAGE2(PG8_SA(0, 0), cA, vA, rA, ck); PG8_STAGE2(PG8_SA(0, 1), cA + hs, vA, rA, ck);
    if (wr == 1) PG8_BAR;
    PG8_WAIT_V(2); PG8_BAR;
    PG8_STAGE2(PG8_SB(1, 0), cB + kstep, vB, rB, ck); PG8_STAGE2(PG8_SA(1, 0), cA + kstep, vA, rA, ck); PG8_STAGE2(PG8_SB(1, 1), cB + hs + kstep, vB, rB, ck);
    PG8_WAIT_V(6); PG8_BAR;
    for (;;) {
        bool has_next; int nk; unsigned nA, nB, nhs;
#define PG8_NEXT() do { has_next = S.next(ui + 1, nxt); nk = has_next ? nxt.kind : ck; nA = has_next ? (nk ? gA1 : gA0) + (((unsigned)nxt.pm * BM * 2048u) >> nk) : cA; \
        nB = has_next ? (nk ? gB1 : gB0) + (((unsigned)nxt.pn * BM * 2048u) >> nk) : cB; nhs = (unsigned)(HALF * 2048) >> nk; } while (0)
        const int nt = 16 >> ck;
#define PG8_BODY(t, FIRST) { \
            const bool last = (FIRST) ? false : (t == nt - 2); \
            const bool relax = (FIRST) && (ui > 0); \
            const unsigned a1 = cA + (unsigned)(t + 1) * kstep; \
            const unsigned a2 = last ? nA : cA + (unsigned)(t + 2) * kstep, b2 = last ? nB : cB + (unsigned)(t + 2) * kstep; \
            const unsigned a3 = a2 + kstep, b3 = b2 + kstep; \
            const int k2 = last ? nk : ck; const unsigned hs2 = last ? nhs : hs; \
            PG8_LDB(B0, 0, 0); PG8_LDB(B1, 0, 1); PG8_SCHED; PG8_LDA(At, 0, 0); if (!(FIRST) || ui == 0) PG8_STAGE2(PG8_SA(1, 1), a1 + hs, vA, rA, ck); \
            if ((FIRST) && relax) PG8_WAIT_VN(0); else PG8_WAIT_V(8); \
            PG8_WAIT_L(0); PG8_BAR; PG8_MMA(0, 0, At, B0, FIRST); PG8_MMA(0, 1, At, B1, FIRST); PG8_BAR; PG8_SCHED; \
            PG8_LDA(At, 0, 1); PG8_STAGE2(PG8_SB(0, 0), b2, vB, rB, k2); PG8_STAGE2(PG8_SB(0, 1), b2 + hs2, vB, rB, k2); PG8_STAGE2(PG8_SA(0, 0), a2, vA, rA, k2); \
            if ((FIRST) && relax) PG8_WAIT_VN(6); else PG8_WAIT_V(8); \
            PG8_WAIT_L(0); PG8_BAR; PG8_MMA(1, 0, At, B0, FIRST); PG8_MMA(1, 1, At, B1, FIRST); PG8_BAR; PG8_SCHED; \
            PG8_LDB(B0, 1, 0); PG8_LDB(B1, 1, 1); PG8_SCHED; PG8_LDA(At, 1, 0); PG8_STAGE2(PG8_SA(0, 1), a2 + hs2, vA, rA, k2); \
            if ((FIRST) && relax) PG8_WAIT_VN(8); else PG8_WAIT_V(8); \
            PG8_WAIT_L(0); PG8_BAR; PG8_MMA(0, 0, At, B0, 0); PG8_MMA(0, 1, At, B1, 0); PG8_BAR; PG8_SCHED; \
            PG8_LDA(At, 1, 1); PG8_STAGE2(PG8_SB(1, 0), b3, vB, rB, k2); PG8_STAGE2(PG8_SB(1, 1), b3 + hs2, vB, rB, k2); PG8_STAGE2(PG8_SA(1, 0), a3, vA, rA, k2); \
            if ((FIRST) && relax) PG8_WAIT_VN(14); else PG8_WAIT_V(8); \
            PG8_WAIT_L(0); PG8_BAR; PG8_MMA(1, 0, At, B0, 0); PG8_MMA(1, 1, At, B1, 0); PG8_BAR; PG8_SCHED; }
        PG8_BODY(0, 1)
        PG8_NEXT();
#pragma unroll 1
        for (int t = 2; t < nt; t += 2) PG8_BODY(t, 0)
#undef PG8_NEXT
#undef PG8_BODY
        if (wr == 0) PG8_BAR;
        PG8_STAGE2(PG8_SA(1, 1), nA + kstep + nhs, vA, rA, nk);
        E(acc, cur, ui, wr, wc, fr, fq);
        if (!has_next) break;
        cur = nxt; cA = nA; cB = nB; ck = nk; hs = nhs; ++ui;
        if (wr == 1) PG8_BAR;
    }
    PG8_WAIT_V(0);
    PG8_BAR;
#undef PG8_SA
#undef PG8_SB
#undef PG8_STAGE2
#undef PG8_LDA
#undef PG8_LDB
#undef PG8_MMA
#undef PG8_MMA2
#undef PG8_Z4
#undef PG8_CAT8
#undef PG8_WAIT_V
#undef PG8_WAIT_VR
#undef PG8_WAIT_VN
#undef PG8_WAIT_L
#undef PG8_BAR
#undef PG8_SCHED
}
}

constexpr int NWAVES = 8, NTHR = NWAVES * 64;
constexpr int BATCH = 32, SEQ = 2048, D = 1024, M = BATCH * SEQ;
constexpr int NIN = 5632, SSMW = 512, NGRP = 32, NST = 64, GCH = 16, FF = 4096;
constexpr int LCH = 16, NCHUNK = SEQ / LCH;
constexpr int UAK = 384;
constexpr int BCROWS = BATCH * NCHUNK;
constexpr float EPS = 1e-6f;

constexpr size_t MiB = 1u << 20;
constexpr size_t WS_SS2 = 0;
constexpr size_t WS_SS3 = 4 * MiB;
constexpr size_t WS_BIAS = 8 * MiB;
constexpr size_t WS_GINV = 8 * MiB + 32 * 1024;
constexpr size_t WS_RMS = 8 * MiB + 64 * 1024;
constexpr size_t WS_BAR = 8 * MiB + 512 * 1024;
constexpr size_t WS_BT1 = 9 * MiB;
constexpr size_t WS_BT2A = 20 * MiB;
constexpr size_t WS_BT2B = 22 * MiB;
constexpr size_t WS_BT3 = 24 * MiB;
constexpr size_t WS_BT4 = 26 * MiB;
constexpr size_t WS_BT5 = 34 * MiB;
constexpr size_t WS_TZ = 42 * MiB;
constexpr size_t WS_MS = 48 * MiB;
constexpr size_t WS_BTGS8 = 51 * MiB;
constexpr size_t WS_XN8 = 432 * MiB;
constexpr size_t WS_XN = 64 * MiB;
constexpr size_t WS_Z = 928 * MiB;
constexpr size_t WS_ATAB = 736 * MiB;
constexpr size_t WS_HB = 64 * MiB;
constexpr size_t WS_UA = 192 * MiB;
constexpr size_t WS_CB = 288 * MiB;
constexpr size_t WS_HALO = 416 * MiB, WS_CBH = 424 * MiB;
constexpr size_t WS_GS = 544 * MiB, WS_GC = 672 * MiB;
constexpr size_t WS_YB = 800 * MiB;
constexpr size_t WS_HID = 192 * MiB;
constexpr size_t WS_END = 1024 * MiB;

constexpr int RING_BYTES = 131072;
constexpr int LDS_BYTES = 160 * 1024;

#define GAS __attribute__((address_space(1)))
#define LAS __attribute__((address_space(3)))
typedef unsigned short bf16;
typedef unsigned v4u __attribute__((ext_vector_type(4)));
typedef float f32x4 __attribute__((ext_vector_type(4)));
using pg8::Unit; using pg8::u32x4; using pg8::BM;

struct Args { const float* in[22]; float* out; unsigned char* ws; int ph_lo, ph_hi; };

__device__ __forceinline__ float dpp_shr1(float x) { return __int_as_float(__builtin_amdgcn_update_dpp(0, __float_as_int(x), 0x111, 0xf, 0xf, false)); }
struct EpiG1 {
    static constexpr bool PERM = true, ROWPERM = true, FP8 = false; static constexpr int NST = 8;
    bf16 *UA, *CB; unsigned char *GS8, *GC8; const float* bias; const float* convw; const float* convb; float* HALO; float* CBH;
    const LAS float* PT;
    __device__ __forceinline__ void operator()(const f32x4 (&acc)[2][2][4][2], const Unit& u, int ui, int wr, int wc, int fr, int fq) const {
        asm volatile("" : "+v"(fr), "+v"(fq));
        const int pn = u.pn, cl = wc * 32 + 8 * fq, tok0 = u.pm * BM + wr * 128 + fr * 8;
        if (pn >= 2 && pn < 18) {
            const int q = pn - 2, bcol = pn * 256 + cl, j0 = q * 64 + wc * 16 + fq * 4;
            const f32x4 b_gc = *(const f32x4*)(bias + bcol + 132);
            const LAS float* pb = PT + q * 192 + wc * 16 + fq * 4;
            const f32x4 b_cb = *(const LAS f32x4*)pb, b_cc = *(const LAS f32x4*)(pb + 64), b_cv = *(const LAS f32x4*)(pb + 128);
            const f32x4 w0 = *(const LAS f32x4*)(PT + 3072 + j0), w1 = *(const LAS f32x4*)(PT + 3072 + D + j0), w2 = *(const LAS f32x4*)(PT + 3072 + 2 * D + j0), cbi = *(const LAS f32x4*)(PT + 3072 + 3 * D + j0);
            f32x4 p[8];
#pragma unroll
            for (int ai = 0; ai < 2; ++ai)
#pragma unroll
                for (int m = 0; m < 4; ++m) p[4 * ai + m] = (acc[ai][0][m][1] + b_cc) * (acc[ai][1][m][0] + b_cv);
            f32x4 pm1, pm2;
#pragma unroll
            for (int e = 0; e < 4; ++e) { pm1[e] = dpp_shr1(p[7][e]); pm2[e] = dpp_shr1(p[6][e]); }
            const int hb = tok0 >> 7;
            if (fr == 15) { *(f32x4*)(HALO + ((size_t)hb * 2 + 0) * D + j0) = p[6]; *(f32x4*)(HALO + ((size_t)hb * 2 + 1) * D + j0) = p[7]; }
#pragma unroll
            for (int ai = 0; ai < 2; ++ai)
#pragma unroll
                for (int mp = 0; mp < 2; ++mp) {
                    pg8::u32x2 wv[2]; unsigned gw[2];
#pragma unroll
                    for (int h = 0; h < 2; ++h) { const int m = 2 * mp + h, k = 4 * ai + m;
                        const f32x4 a1 = k >= 1 ? p[k >= 1 ? k - 1 : 0] : pm1, a2 = k >= 2 ? p[k >= 2 ? k - 2 : 0] : (k == 1 ? pm1 : pm2);
                        const f32x4 cbv = acc[ai][0][m][0] + b_cb;
                        const f32x4 cv = cbv * (cbi + w2 * p[k] + w1 * a1 + w0 * a2);
                        wv[h].x = pg8::cvt_pk_bf16(cv[0], cv[1]); wv[h].y = pg8::cvt_pk_bf16(cv[2], cv[3]);
                        if (k < 2 && fr == 0) *(f32x4*)(CBH + ((size_t)hb * 2 + k) * D + j0) = cbv;
                        gw[h] = pg8::sig255_pk(acc[ai][1][m][1] + b_gc); }
                    const auto sx = __builtin_amdgcn_permlane16_swap(wv[0].x, wv[1].x, false, false), sy = __builtin_amdgcn_permlane16_swap(wv[0].y, wv[1].y, false, false), sg = __builtin_amdgcn_permlane16_swap(gw[0], gw[1], false, false);
                    const size_t row = (size_t)(tok0 + 4 * ai + 2 * mp + (fq & 1)); const int jc = q * 64 + wc * 16 + 8 * (fq >> 1);
                    u32x4 o; o.x = sx[0]; o.y = sy[0]; o.z = sx[1]; o.w = sy[1];
                    *(u32x4*)(CB + row * D + jc) = o;
                    pg8::u32x2 og; og.x = sg[0]; og.y = sg[1];
                    *(pg8::u32x2*)(GC8 + row * D + jc) = og; }
        } else {
#pragma unroll
            for (int bj = 0; bj < 2; ++bj) { const int ch = pn * 256 + bj * 128 + cl, gidx = ch >> 4, c0 = ch & 15;
                const f32x4 b0 = *(const f32x4*)(bias + ch), b1 = *(const f32x4*)(bias + ch + 4);
#pragma unroll
                for (int ai = 0; ai < 2; ++ai)
#pragma unroll
                    for (int m = 0; m < 4; ++m) { const int tok = tok0 + 4 * ai + m, bc = tok >> 4, jt = tok & 15;
                        *(u32x4*)(UA + ((size_t)gidx * BCROWS + bc) * UAK + jt * 16 + c0) = pg8::pack8(acc[ai][bj][m][0] + b0, acc[ai][bj][m][1] + b1); } }
        }
    }
};
struct EpiGS8 {
    static constexpr bool PERM = true, ROWPERM = false, FP8 = true; static constexpr int NST = 8;
    unsigned char* GS8; const float* bias;
    __device__ __forceinline__ void operator()(const f32x4 (&acc)[2][2][4][2], const Unit& u, int ui, int wr, int wc, int fr, int fq) const {
        asm volatile("" : "+v"(fr), "+v"(fq));
        const int rb = u.pm * BM + wr * 64 + fr, cl = wc * 32 + 8 * fq;
#pragma unroll
        for (int bj = 0; bj < 2; ++bj) { const int col = u.pn * 256 + bj * 128 + cl;
            const f32x4 b0 = *(const f32x4*)(bias + col), b1 = *(const f32x4*)(bias + col + 4);
#pragma unroll
            for (int ai = 0; ai < 2; ++ai)
#pragma unroll
                for (int mp = 0; mp < 2; ++mp) { pg8::u32x2 w[2];
#pragma unroll
                    for (int h = 0; h < 2; ++h) { const int m = 2 * mp + h; w[h].x = pg8::sig255_pk(acc[ai][bj][m][0] + b0); w[h].y = pg8::sig255_pk(acc[ai][bj][m][1] + b1); }
                    const auto sx = __builtin_amdgcn_permlane16_swap(w[0].x, w[1].x, false, false), sy = __builtin_amdgcn_permlane16_swap(w[0].y, w[1].y, false, false);
                    const size_t row = (size_t)(rb + ai * 128 + (2 * mp + (fq & 1)) * 16);
                    u32x4 o; o.x = sx[0]; o.y = sy[0]; o.z = sx[1]; o.w = sy[1];
                    *(u32x4*)(GS8 + row * D + (col - 8 * (fq & 1))) = o; } }
    }
};
template <int N> __device__ __forceinline__ float dpp_shr(float x) { return __int_as_float(__builtin_amdgcn_update_dpp(0, __float_as_int(x), 0x110 + N, 0xf, 0xf, false)); }
template <int N> __device__ __forceinline__ f32x4 dpp_shr4(const f32x4& x) { return (f32x4){dpp_shr<N>(x[0]), dpp_shr<N>(x[1]), dpp_shr<N>(x[2]), dpp_shr<N>(x[3])}; }
struct EpiS1 {
    static constexpr bool PERM = false, ROWPERM = true, FP8 = false; static constexpr int NST = 16;
    bf16* UA; const float* ATAB;
    __device__ __forceinline__ void operator()(const f32x4 (&acc)[2][2][4][2], const Unit& u, int ui, int wr, int wc, int fr, int fq) const {
        asm volatile("" : "+v"(fr), "+v"(fq));
        const int gidx = u.pm >> 4, n0 = 16 * wc + 4 * fq;
        const float* tb = ATAB + (size_t)gidx * 640 + n0;
        const f32x4 ar = *(const f32x4*)tb, ai_ = *(const f32x4*)(tb + 64);
        f32x4 tr = {0.f, 0.f, 0.f, 0.f}, ti = {0.f, 0.f, 0.f, 0.f};
#pragma unroll
        for (int ai = 0; ai < 2; ++ai)
#pragma unroll
            for (int m = 0; m < 4; ++m) { const f32x4 t = ar * tr - ai_ * ti + acc[ai][0][m][0]; ti = ar * ti + ai_ * tr + acc[ai][0][m][1]; tr = t; }
#define S1_STEP(N, q) { const f32x4 pr = *(const f32x4*)(tb + 128 * (q)), pi = *(const f32x4*)(tb + 128 * (q) + 64); const f32x4 yr = dpp_shr4<N>(tr), yi = dpp_shr4<N>(ti); \
            tr += pr * yr - pi * yi; ti += pr * yi + pi * yr; }
        S1_STEP(1, 1) S1_STEP(2, 2) S1_STEP(4, 3) S1_STEP(8, 4)
#undef S1_STEP
        f32x4 sr = dpp_shr4<1>(tr), si = dpp_shr4<1>(ti);
        bf16* row = UA + ((size_t)u.pm * BM + wr * 128 + fr * 8) * UAK + 256 + n0;
#pragma unroll
        for (int ai = 0; ai < 2; ++ai)
#pragma unroll
            for (int m = 0; m < 4; ++m) { bf16* rp = row + (size_t)(ai * 4 + m) * UAK;
                pg8::u32x2 o; o.x = pg8::cvt_pk_bf16(sr[0], sr[1]); o.y = pg8::cvt_pk_bf16(sr[2], sr[3]); *(pg8::u32x2*)rp = o;
                o.x = pg8::cvt_pk_bf16(si[0], si[1]); o.y = pg8::cvt_pk_bf16(si[2], si[3]); *(pg8::u32x2*)(rp + 64) = o;
                const f32x4 t = ar * sr - ai_ * si + acc[ai][0][m][0]; si = ar * si + ai_ * sr + acc[ai][0][m][1]; sr = t; }
    }
};
struct EpiS3 {
    static constexpr bool PERM = true, ROWPERM = false, FP8 = false; static constexpr int NST = 16;
    bf16* Z;
    __device__ __forceinline__ void operator()(const f32x4 (&acc)[2][2][4][2], const Unit& u, int ui, int wr, int wc, int fr, int fq) const {
        asm volatile("" : "+v"(fr), "+v"(fq));
        const int gidx = u.pm >> 4, co0 = (fq & 1) * 8;
#pragma unroll
        for (int ai = 0; ai < 2; ++ai)
#pragma unroll
            for (int m = 0; m < 4; ++m) { const int bc = ((u.pm & 15) * BM) + ai * 128 + wr * 64 + m * 16 + fr;
#pragma unroll
                for (int bj = 0; bj < 2; ++bj) { const int j = bj * 8 + wc * 2 + (fq >> 1);
                    f32x4 x0 = acc[ai][bj][m][0], x1 = acc[ai][bj][m][1];
#pragma unroll
                    for (int e = 0; e < 4; ++e) { x0[e] = pg8::gelu_tanh_f(x0[e]); x1[e] = pg8::gelu_tanh_f(x1[e]); }
                    *(u32x4*)(Z + ((size_t)bc * LCH + j) * SSMW + gidx * 16 + co0) = pg8::pack8(x0, x1); } }
    }
};
__device__ __forceinline__ void unpack_u8x8(const pg8::u32x2& w, f32x4& a, f32x4& b) {
    a = (f32x4){(float)(w.x & 0xffu), (float)((w.x >> 8) & 0xffu), (float)((w.x >> 16) & 0xffu), (float)(w.x >> 24)};
    b = (f32x4){(float)(w.y & 0xffu), (float)((w.y >> 8) & 0xffu), (float)((w.y >> 16) & 0xffu), (float)(w.y >> 24)}; }
__device__ __forceinline__ void load_gate_pair(const unsigned char* Gt, size_t off0, int fq, pg8::u32x2& w0, pg8::u32x2& w1) {
    const u32x4 L = *(const u32x4*)(Gt + off0 + (size_t)(fq & 1) * (16 * D - 8));
    const auto sx = __builtin_amdgcn_permlane16_swap(L.x, L.z, false, false), sy = __builtin_amdgcn_permlane16_swap(L.y, L.w, false, false);
    w0.x = sx[0]; w0.y = sy[0]; w1.x = sx[1]; w1.y = sy[1]; }
struct EpiG2b {
    static constexpr bool PERM = true, ROWPERM = false, FP8 = false; static constexpr int NST = 16;
    const unsigned char* GC8; bf16* O;
    __device__ __forceinline__ void operator()(const f32x4 (&acc)[2][2][4][2], const Unit& u, int ui, int wr, int wc, int fr, int fq) const {
        asm volatile("" : "+v"(fr), "+v"(fq));
        const int rb = u.pm * BM + wr * 64 + fr, cb = u.pn * 256 + wc * 32 + 8 * fq;
#pragma unroll
        for (int ai = 0; ai < 2; ++ai)
#pragma unroll
            for (int mp = 0; mp < 2; ++mp) { const size_t off = (size_t)(rb + ai * 128 + mp * 32) * D + cb;
#pragma unroll
                for (int bj = 0; bj < 2; ++bj) { pg8::u32x2 w[2]; load_gate_pair(GC8, off + bj * 128, fq, w[0], w[1]);
#pragma unroll
                    for (int h = 0; h < 2; ++h) { f32x4 g0, g1; unpack_u8x8(w[h], g0, g1);
                        *(u32x4*)(O + off + (size_t)h * 16 * D + bj * 128) = pg8::pack8(g0 * acc[ai][bj][2 * mp + h][0], g1 * acc[ai][bj][2 * mp + h][1]); } } }
    }
};
struct EpiG2a {
    static constexpr bool PERM = true, ROWPERM = false, FP8 = false; static constexpr int NST = 8;
    const unsigned char* GS8; const bf16* YBi; bf16* O;
    __device__ __forceinline__ void operator()(const f32x4 (&acc)[2][2][4][2], const Unit& u, int ui, int wr, int wc, int fr, int fq) const {
        asm volatile("" : "+v"(fr), "+v"(fq));
        const int rb = u.pm * BM + wr * 64 + fr, cb = u.pn * 128 + wc * 32 + 8 * fq;
#pragma unroll
        for (int ai = 0; ai < 2; ++ai)
#pragma unroll
            for (int mp = 0; mp < 2; ++mp) { pg8::u32x2 wgp[2]; load_gate_pair(GS8, (size_t)(rb + ai * 128 + mp * 32) * D + cb, fq, wgp[0], wgp[1]);
#pragma unroll
              for (int h = 0; h < 2; ++h) { const int m = 2 * mp + h; const size_t off = (size_t)(rb + ai * 128 + m * 16) * D + cb;
                const pg8::u32x2 wg = wgp[h]; const u32x4 wy = *(const u32x4*)(YBi + off); f32x4 g0, g1, y0, y1; unpack_u8x8(wg, g0, g1); pg8::unpack8(wy, y0, y1);
                const f32x4 b0 = acc[ai][1][m][0], b1 = acc[ai][1][m][1];
                f32x4 d0 = {__builtin_amdgcn_exp2f(b0[0]), __builtin_amdgcn_exp2f(b0[1]), __builtin_amdgcn_exp2f(b0[2]), __builtin_amdgcn_exp2f(b0[3])}, d1 = {__builtin_amdgcn_exp2f(b1[0]), __builtin_amdgcn_exp2f(b1[1]), __builtin_amdgcn_exp2f(b1[2]), __builtin_amdgcn_exp2f(b1[3])};
                d0 = d0 + 1.0f; d1 = d1 + 1.0f;
                const f32x4 r0 = {__builtin_amdgcn_rcpf(d0[0]), __builtin_amdgcn_rcpf(d0[1]), __builtin_amdgcn_rcpf(d0[2]), __builtin_amdgcn_rcpf(d0[3])}, r1 = {__builtin_amdgcn_rcpf(d1[0]), __builtin_amdgcn_rcpf(d1[1]), __builtin_amdgcn_rcpf(d1[2]), __builtin_amdgcn_rcpf(d1[3])};
                const f32x4 a0 = (g0 * acc[ai][0][m][0]) * r0 + y0, a1 = (g1 * acc[ai][0][m][1]) * r1 + y1;
                *(u32x4*)(O + off) = pg8::pack8(a0, a1); } }
    }
};
struct EpiG2ab {
    static constexpr bool PERM = true, ROWPERM = false, FP8 = false; static constexpr int NST = 8;
    EpiG2b e0; EpiG2a e1;
    __device__ __forceinline__ void operator()(const f32x4 (&acc)[2][2][4][2], const Unit& u, int ui, int wr, int wc, int fr, int fq) const {
        if (u.kind == 0) e0(acc, u, ui, wr, wc, fr, fq); else e1(acc, u, ui, wr, wc, fr, fq); }
};
struct EpiRes6 {
    static constexpr bool PERM = true, ROWPERM = false, FP8 = false; static constexpr int NST = 16;
    bf16* XH; const float* GINV; const LAS float* RMSL; float* SS;
    __device__ __forceinline__ void operator()(const f32x4 (&acc)[2][2][4][2], const Unit& u, int ui, int wr, int wc, int fr, int fq) const {
        asm volatile("" : "+v"(fr), "+v"(fq));
        const int rt = wr * 64 + fr, cb = u.pn * 256 + wc * 32 + 8 * fq;
        f32x4 gi[2][2]; float s8[8];
#pragma unroll
        for (int bj = 0; bj < 2; ++bj) { gi[bj][0] = *(const f32x4*)(GINV + cb + bj * 128); gi[bj][1] = *(const f32x4*)(GINV + cb + bj * 128 + 4); }
#pragma unroll
        for (int ai = 0; ai < 2; ++ai)
#pragma unroll
            for (int m = 0; m < 4; ++m) { const int r = rt + ai * 128 + m * 16; const size_t row = (size_t)(u.pm * BM + r), off = row * D + cb; f32x4 sv = {0.f, 0.f, 0.f, 0.f};
                const float rms = RMSL[ui * 256 + r];
#pragma unroll
                for (int bj = 0; bj < 2; ++bj) { const u32x4 w = *(const u32x4*)(XH + off + bj * 128); f32x4 x0, x1; pg8::unpack8(w, x0, x1);
                    const f32x4 h0 = x0 * rms * gi[bj][0] + acc[ai][bj][m][0], h1 = x1 * rms * gi[bj][1] + acc[ai][bj][m][1];
                    *(u32x4*)(XH + off + bj * 128) = pg8::pack8(h0, h1);
                    sv += h0 * h0; sv += h1 * h1; }
                float s = (sv[0] + sv[1]) + (sv[2] + sv[3]);
                s += __shfl_xor(s, 16); s += __shfl_xor(s, 32); s8[4 * ai + m] = s; }
#pragma unroll
        for (int j = 0; j < 2; ++j) { const float sel = fq == 0 ? s8[j] : fq == 1 ? s8[2 + j] : fq == 2 ? s8[4 + j] : s8[6 + j]; const int idx = 2 * fq + j;
            SS[(size_t)(u.pm * BM + rt + (idx >> 2) * 128 + (idx & 3) * 16) * 16 + u.pn * 4 + wc] = sel; }
    }
};
struct EpiRes8 {
    static constexpr bool PERM = true, ROWPERM = false, FP8 = false; static constexpr int NST = 16;
    bf16* HBio; float* SS;
    __device__ __forceinline__ void operator()(const f32x4 (&acc)[2][2][4][2], const Unit& u, int ui, int wr, int wc, int fr, int fq) const {
        asm volatile("" : "+v"(fr), "+v"(fq));
        const int rb = u.pm * BM + wr * 64 + fr, cb = u.pn * 256 + wc * 32 + 8 * fq; float s8[8];
#pragma unroll
        for (int ai = 0; ai < 2; ++ai)
#pragma unroll
            for (int m = 0; m < 4; ++m) { const size_t row = (size_t)(rb + ai * 128 + m * 16), off = row * D + cb; f32x4 sv = {0.f, 0.f, 0.f, 0.f};
#pragma unroll
                for (int bj = 0; bj < 2; ++bj) { const u32x4 w = *(const u32x4*)(HBio + off + bj * 128); f32x4 x0, x1; pg8::unpack8(w, x0, x1);
                    const f32x4 h0 = x0 + acc[ai][bj][m][0], h1 = x1 + acc[ai][bj][m][1];
                    *(u32x4*)(HBio + off + bj * 128) = pg8::pack8(h0, h1);
                    sv += h0 * h0; sv += h1 * h1; }
                float s = (sv[0] + sv[1]) + (sv[2] + sv[3]);
                s += __shfl_xor(s, 16); s += __shfl_xor(s, 32); s8[4 * ai + m] = s; }
#pragma unroll
        for (int j = 0; j < 2; ++j) { const float sel = fq == 0 ? s8[j] : fq == 1 ? s8[2 + j] : fq == 2 ? s8[4 + j] : s8[6 + j]; const int idx = 2 * fq + j;
            SS[(size_t)(rb + (idx >> 2) * 128 + (idx & 3) * 16) * 16 + u.pn * 4 + wc] = sel; }
    }
};
struct EpiG4 {
    static constexpr bool PERM = true, ROWPERM = false, FP8 = false; static constexpr int NST = 16;
    bf16* HID; const LAS float* RI2;
    __device__ __forceinline__ void operator()(const f32x4 (&acc)[2][2][4][2], const Unit& u, int ui, int wr, int wc, int fr, int fq) const {
        asm volatile("" : "+v"(fr), "+v"(fq));
        const int rt = wr * 64 + fr, cb = u.pn * 256 + wc * 32 + 8 * fq;
#pragma unroll
        for (int ai = 0; ai < 2; ++ai)
#pragma unroll
            for (int m = 0; m < 4; ++m) { const int r = rt + ai * 128 + m * 16; const size_t row = (size_t)(u.pm * BM + r);
                const float ri2 = RI2[ui * 256 + r];
#pragma unroll
                for (int bj = 0; bj < 2; ++bj) { f32x4 x0 = acc[ai][bj][m][0], x1 = acc[ai][bj][m][1], p0, p1;
#pragma unroll
                    for (int e = 0; e < 4; ++e) { p0[e] = pg8::relu_f(x0[e]); p1[e] = pg8::relu_f(x1[e]); }
                    x0 = x0 * p0 * ri2; x1 = x1 * p1 * ri2;
                    __builtin_nontemporal_store(pg8::pack8(x0, x1), (u32x4*)(HID + row * FF + cb + bj * 128)); } }
    }
};

#define XB_TMO      128
#define XB_XCNT(j)  (256  + 64 * (j))
#define XB_XSUB(j)  (1280 + 64 * (j))
#define XB_XGEN(j)  (2304 + 64 * (j))
#define XB_TOP      3328
#define XB_TOPGEN   3392
#define XB_XSUB2(j) (3456 + 64 * (j))
#define XB_XGEN2(j) (4480 + 64 * (j))
#define XCD_BAR_WORDS 5504
#define XB_SPIN_CAP (1u << 18)
__device__ __forceinline__ unsigned xb_ld(unsigned* p)              { return __hip_atomic_load(p, __ATOMIC_RELAXED, __HIP_MEMORY_SCOPE_AGENT); }
__device__ __forceinline__ unsigned xb_add(unsigned* p, unsigned v) { return __hip_atomic_fetch_add(p, v, __ATOMIC_RELAXED, __HIP_MEMORY_SCOPE_AGENT); }
__device__ __forceinline__ unsigned xb_xcc_id() { return (unsigned)__builtin_amdgcn_s_getreg((3 << 11) | 20) & 0xFu; }
#define XB_SPIN(cond, bar) do { unsigned _sp = 0; while (cond) { __builtin_amdgcn_s_sleep(1); \
    if ((++_sp & 255u) == 0u) { if (xb_ld(&(bar)[XB_TMO])) break; if (_sp > XB_SPIN_CAP) { atomicAdd(&(bar)[XB_TMO], 1u); break; } } } } while (0)
struct XcdBarrier { unsigned* bar; unsigned x; volatile LAS unsigned* st; };
__device__ __forceinline__ XcdBarrier xcd_barrier_post(unsigned* bar, volatile LAS unsigned* st) {
    XcdBarrier b; b.bar = bar; b.x = xb_xcc_id(); b.st = st;
    if (threadIdx.x == 0) { st[2] = b.x; st[3] = xb_add(&bar[XB_XCNT(b.x)], 1u); }
    return b;
}
__device__ __forceinline__ void xcd_barrier_complete(unsigned* bar, unsigned x, unsigned& nloc, unsigned& nx, unsigned& uniform) {
    const unsigned G = gridDim.x * gridDim.y * gridDim.z;
    unsigned sum, cnt, mine, n32, sp = 0u;
    for (;;) {
        sum = 0u; cnt = 0u; mine = 0u; n32 = 0u;
#pragma unroll
        for (unsigned j = 0; j < 16; ++j) { const unsigned c = xb_ld(&bar[XB_XCNT(j)]); sum += c; cnt += (c > 0u) ? 1u : 0u; n32 += (c == 32u) ? 1u : 0u; mine = (j == x) ? c : mine; }
        if (sum == G) break;
        __builtin_amdgcn_s_sleep(1);
        if ((++sp & 255u) == 0u) { if (xb_ld(&bar[XB_TMO])) break; if (sp > XB_SPIN_CAP) { atomicAdd(&bar[XB_TMO], 1u); break; } }
    }
    nloc = mine > 0u ? mine : 1u; nx = cnt > 0u ? cnt : 1u;
    uniform = (sum == 256u && cnt == 8u && n32 == 8u) ? 1u : 0u;
    if (uniform) { for (unsigned j = 8; j < 16; ++j) if (xb_ld(&bar[XB_XCNT(j)]) != 0u) uniform = 0u; }
}
__device__ __forceinline__ void xcd_barrier(const XcdBarrier& b) {
    asm volatile("s_waitcnt vmcnt(0)" ::: "memory");
    __syncthreads();
    if (threadIdx.x == 0) {
        unsigned* bar = b.bar;
        __builtin_amdgcn_s_waitcnt(0);
        unsigned nloc = b.st[0], nx = b.st[1];
        if (nloc == 0u) { unsigned uni = 0u; xcd_barrier_complete(bar, b.x, nloc, nx, uni); b.st[0] = nloc; b.st[1] = nx; b.st[4] = uni; }
        const unsigned old = xb_add(&bar[XB_XSUB(b.x)], 1u);
        const unsigned gen = old / nloc;
        if (old + 1u == (gen + 1u) * nloc) {
            __builtin_amdgcn_fence(__ATOMIC_RELEASE, "agent");
            asm volatile("s_waitcnt vmcnt(0)" ::: "memory");
            const unsigned og = xb_add(&bar[XB_TOP], 1u);
            const unsigned tg = og / nx;
            if (og + 1u == (tg + 1u) * nx) xb_add(&bar[XB_TOPGEN], 1u);
            else XB_SPIN(xb_ld(&bar[XB_TOPGEN]) == tg, bar);
            __builtin_amdgcn_fence(__ATOMIC_ACQUIRE, "agent");
            xb_add(&bar[XB_XGEN(b.x)], 1u);
            asm volatile("s_waitcnt vmcnt(0)" ::: "memory");
        } else {
            XB_SPIN(xb_ld(&bar[XB_XGEN(b.x)]) == gen, bar);
            __builtin_amdgcn_fence(__ATOMIC_ACQUIRE, "agent");
            asm volatile("s_waitcnt vmcnt(0)" ::: "memory");
        }
    }
    __syncthreads();
}

__device__ __forceinline__ void xcd_barrier_local(const XcdBarrier& b) {
    asm volatile("s_waitcnt vmcnt(0)" ::: "memory");
    __syncthreads();
    if (threadIdx.x == 0) {
        unsigned* bar = b.bar;
        __builtin_amdgcn_s_waitcnt(0);
        const unsigned nloc = b.st[0];
        const unsigned old = xb_add(&bar[XB_XSUB2(b.x)], 1u);
        const unsigned gen = old / nloc;
        if (old + 1u == (gen + 1u) * nloc) xb_add(&bar[XB_XGEN2(b.x)], 1u);
        else XB_SPIN(xb_ld(&bar[XB_XGEN2(b.x)]) == gen, bar);
        __builtin_amdgcn_fence(__ATOMIC_ACQUIRE, "agent");
        asm volatile("s_waitcnt vmcnt(0)" ::: "memory");
    }
    __syncthreads();
}

__device__ __forceinline__ float wave_sum(float v) {
#pragma unroll
    for (int o = 1; o < 64; o <<= 1) v += __shfl_xor(v, o);
    return v;
}
__device__ __forceinline__ int bt1_src_col(int r);
__device__ __forceinline__ float bt1_row_scale(int r);
template <bool BT1MAP = false, bool FP8OUT = false>
__device__ __forceinline__ void p0_transpose_item(const float* W, int K, int N, bf16* WT, int dst_row0, int src_col0, int k0, const float* kscale, LAS float* scr, int lane, float osc = 1.0f) {
    const int kq = lane >> 3, nq = (lane & 7) * 4; f32x4 v[8];
    if (BT1MAP) src_col0 = bt1_src_col(dst_row0 + nq) - nq;
#pragma unroll
    for (int i = 0; i < 8; ++i) v[i] = *(const f32x4*)(W + (size_t)(k0 + 8 * i + kq) * N + src_col0 + nq);
    if (BT1MAP) osc = bt1_row_scale(dst_row0 + nq);
#pragma unroll
    for (int i = 0; i < 8; ++i) { const int kk = 8 * i + kq; const float sc = (kscale ? kscale[k0 + kk] : 1.0f) * osc;
#pragma unroll
        for (int e = 0; e < 4; ++e) scr[kk * 33 + nq + e] = v[i][e] * sc; }
    asm volatile("s_waitcnt lgkmcnt(0)" ::: "memory");
    const int c = lane & 7;
#pragma unroll
    for (int j = 0; j < 4; ++j) { const int n = (lane >> 3) + 8 * j; const LAS float* sp = scr + (8 * c) * 33 + n;
        v4u o; o.x = pg8::cvt_pk_bf16(sp[0 * 33], sp[1 * 33]); o.y = pg8::cvt_pk_bf16(sp[2 * 33], sp[3 * 33]); o.z = pg8::cvt_pk_bf16(sp[4 * 33], sp[5 * 33]); o.w = pg8::cvt_pk_bf16(sp[6 * 33], sp[7 * 33]);
        if (FP8OUT) { pg8::u32x2 w8; w8.x = __builtin_amdgcn_cvt_pk_fp8_f32(sp[0 * 33] * FP8_WMUL, sp[1 * 33] * FP8_WMUL, 0u, false); w8.x = __builtin_amdgcn_cvt_pk_fp8_f32(sp[2 * 33] * FP8_WMUL, sp[3 * 33] * FP8_WMUL, w8.x, true);
            w8.y = __builtin_amdgcn_cvt_pk_fp8_f32(sp[4 * 33] * FP8_WMUL, sp[5 * 33] * FP8_WMUL, 0u, false); w8.y = __builtin_amdgcn_cvt_pk_fp8_f32(sp[6 * 33] * FP8_WMUL, sp[7 * 33] * FP8_WMUL, w8.y, true);
            *(pg8::u32x2*)((unsigned char*)WT + (size_t)(dst_row0 + n) * K + k0 + 8 * c) = w8; }
        else *(v4u*)(WT + (size_t)(dst_row0 + n) * K + k0 + 8 * c) = o; }
    asm volatile("s_waitcnt lgkmcnt(0)" ::: "memory");
}
__device__ __forceinline__ int bt1_src_col(int r) {
    if (r < 512) return r;
    if (r >= 4608) return 3584 + (r - 4608);
    const int t = r - 512, q = t >> 8, c = t & 255, bj = c >> 7, wc = (c >> 5) & 3, fq = (c >> 3) & 3, n = (c >> 2) & 1, e = c & 3, T = 2 * bj + n, j = 64 * q + 16 * wc + 4 * fq + e;
    return (T == 0 ? 512 : T == 1 ? 1536 : T == 2 ? 2560 : 4608) + j; }

#define NLOG2E (-1.4426950408889634f)
__device__ __forceinline__ float bt1_row_scale(int r) { const int t = r - 512; return (r >= 512 && r < 4608 && (t & 128) && (t & 4)) ? NLOG2E : 1.0f; }

__global__ void __launch_bounds__(NTHR, 2) fwd_megakernel(Args args) {
    extern __shared__ __attribute__((aligned(16))) unsigned char lds_raw[];
    LAS unsigned char* lds = (LAS unsigned char*)lds_raw;
    const int tid = threadIdx.x, lane = tid & 63, wave = __builtin_amdgcn_readfirstlane(tid >> 6);
    const int G = gridDim.x, bx = blockIdx.x;
    const int vcu = (G % 8 == 0) ? (bx % 8) * (G / 8) + bx / 8 : bx;
    unsigned char* ws = args.ws;
    if (tid < 8) ((LAS unsigned*)(lds + RING_BYTES))[tid] = 0u;
    __syncthreads();
    const XcdBarrier bar = xcd_barrier_post((unsigned*)(ws + WS_BAR), (volatile LAS unsigned*)(lds + RING_BYTES));
    const float* x = args.in[0];
    float* SS2 = (float*)(ws + WS_SS2); float* SS3 = (float*)(ws + WS_SS3); float* BIASP = (float*)(ws + WS_BIAS);
    bf16* BT1 = (bf16*)(ws + WS_BT1); bf16* BT2A = (bf16*)(ws + WS_BT2A); bf16* BT2B = (bf16*)(ws + WS_BT2B); bf16* BT3 = (bf16*)(ws + WS_BT3);
    bf16* BT4 = (bf16*)(ws + WS_BT4); bf16* BT5 = (bf16*)(ws + WS_BT5); bf16* TZ = (bf16*)(ws + WS_TZ); bf16* MS = (bf16*)(ws + WS_MS);
    bf16* XN = (bf16*)(ws + WS_XN); bf16* Z = (bf16*)(ws + WS_Z); float* ATAB = (float*)(ws + WS_ATAB); bf16* HB = (bf16*)(ws + WS_HB);
    bf16* UA = (bf16*)(ws + WS_UA); bf16* CB = (bf16*)(ws + WS_CB); float* HALO = (float*)(ws + WS_HALO); float* CBH = (float*)(ws + WS_CBH); unsigned char* GS8 = ws + WS_GS; unsigned char* GC8 = ws + WS_GC; bf16* YB = (bf16*)(ws + WS_YB); float* RMS = (float*)(ws + WS_RMS); float* GINV = (float*)(ws + WS_GINV);
    bf16* HID = (bf16*)(ws + WS_HID);
    const int lo = args.ph_lo, hi = args.ph_hi;
#define IN(k) (lo <= (k) && (k) < hi)
#define SEAM(k) do { if (IN(k) && IN((k) + 1)) { if ((k) >= 1 && local_ok) xcd_barrier_local(bar); else xcd_barrier(bar); } } while (0)
    const int gw = vcu * NWAVES + wave, NGW = G * NWAVES;
    bool local_ok = false; int c = bx;

    if (IN(0)) {
        for (int task = bx; task < NGRP * 8; task += G) {
            const int gidx = task >> 3, part = task & 7;
            LAS float* L = (LAS float*)lds;
            LAS float* APR = L; LAS float* API = L + 17 * 64; LAS float* BBR = L + 2 * 17 * 64; LAS float* BBI = BBR + 1024; LAS float* CTR = BBI + 1024; LAS float* CTI = CTR + 1024; LAS float* KT = CTI + 1024;
            const float* lam_re = args.in[4] + gidx * 64; const float* lam_im = args.in[5] + gidx * 64; const float dt = expf(args.in[6][gidx]);
            const float* bre = args.in[7] + gidx * 1024; const float* bim = args.in[8] + gidx * 1024; const float* cre = args.in[9] + gidx * 1024; const float* cim = args.in[10] + gidx * 1024;
            __syncthreads();
            if (tid < 64) { const int n = tid; const float lr = lam_re[n], li = lam_im[n];
                const float xm = lr * dt, mag = expf(xm), th = li * dt; const float sn = sinf(th), cs = cosf(th), sh = sinf(0.5f * th);
                const float ar = mag * cs, aim = mag * sn;
                const float er = expm1f(xm) * cs - 2.0f * sh * sh, ei = aim, den = lr * lr + li * li;
                const float qr = (er * lr + ei * li) / den, qi = (ei * lr - er * li) / den;
                float pr = 1.f, pi = 0.f;
                for (int k = 0; k <= 16; ++k) { APR[k * 64 + n] = pr; API[k * 64 + n] = pi; const float t = pr * ar - pi * aim; pi = pr * aim + pi * ar; pr = t; }
                if (part == 0) { float* T = ATAB + (size_t)gidx * 640 + n; float qr16 = cs, qi16 = sn;
#pragma unroll
                    for (int q = 0; q < 4; ++q) { const float t = qr16 * qr16 - qi16 * qi16; qi16 = 2.0f * qr16 * qi16; qr16 = t; }
                    const float m16 = expf(16.0f * xm); qr16 *= m16; qi16 *= m16; T[0] = qr16; T[64] = qi16;
#pragma unroll
                    for (int q = 0; q < 3; ++q) { const float t = qr16 * qr16 - qi16 * qi16; qi16 = 2.0f * qr16 * qi16; qr16 = t; }
#pragma unroll
                    for (int q = 1; q <= 4; ++q) { T[128 * q] = qr16; T[128 * q + 64] = qi16; const float t = qr16 * qr16 - qi16 * qi16; qi16 = 2.0f * qr16 * qi16; qr16 = t; } }
                for (int ci = 0; ci < 16; ++ci) { const float br = bre[n * 16 + ci], bi = bim[n * 16 + ci]; BBR[n * 16 + ci] = qr * br - qi * bi; BBI[n * 16 + ci] = qr * bi + qi * br; }
            }
            for (int idx = tid; idx < 1024; idx += NTHR) { const int co = idx >> 6, n = idx & 63; CTR[n * 16 + co] = cre[idx]; CTI[n * 16 + co] = cim[idx]; }
            __syncthreads();
            for (int idx = tid; idx < 4096; idx += NTHR) { const int k = idx >> 8, co = (idx >> 4) & 15, ci = idx & 15; float s = 0.f;
                for (int n = 0; n < 64; ++n) { const float cr = CTR[n * 16 + co], cim_ = CTI[n * 16 + co], pr = APR[k * 64 + n], pi = API[k * 64 + n];
                    const float wre = cr * pr - cim_ * pi, wim = cr * pi + cim_ * pr; s += wre * BBR[n * 16 + ci] - wim * BBI[n * 16 + ci]; }
                if (k == 0 && co == ci) s += args.in[11][gidx * 16 + co];
                KT[idx] = s; }
            __syncthreads();
            for (int id = tid; id < 32 * 48; id += NTHR) { const int rr = id / 48, c8 = id % 48, j = part * 2 + (rr >> 4), co = rr & 15; float v[8];
                if (c8 < 32) { const int i = c8 >> 1, ci0 = (c8 & 1) * 8;
#pragma unroll
                    for (int e = 0; e < 8; ++e) v[e] = (i <= j) ? KT[((j - i) & 15) * 256 + co * 16 + ci0 + e] : 0.f;
                } else { const bool im = c8 >= 40; const int n0 = (c8 - (im ? 40 : 32)) * 8;
#pragma unroll
                    for (int e = 0; e < 8; ++e) { const int n = n0 + e; const float cr = CTR[n * 16 + co], cim_ = CTI[n * 16 + co], pr = APR[(j + 1) * 64 + n], pi = API[(j + 1) * 64 + n];
                        v[e] = im ? -(cr * pi + cim_ * pr) : (cr * pr - cim_ * pi); } }
                v4u o; o.x = pg8::cvt_pk_bf16(v[0], v[1]); o.y = pg8::cvt_pk_bf16(v[2], v[3]); o.z = pg8::cvt_pk_bf16(v[4], v[5]); o.w = pg8::cvt_pk_bf16(v[6], v[7]);
                *(v4u*)(TZ + ((size_t)(gidx * 256 + part * 32 + rr)) * UAK + c8 * 8) = o; }
            { const int rr = tid >> 5, c8 = tid & 31, rho = part * 16 + rr, im = (rho >> 4) & 1, n = ((rho >> 5) << 4) + (rho & 15), i = c8 >> 1, ci0 = (c8 & 1) * 8; float v[8];
                const float pr = APR[(15 - i) * 64 + n], pi = API[(15 - i) * 64 + n];
#pragma unroll
                for (int e = 0; e < 8; ++e) { const float br = BBR[n * 16 + ci0 + e], bi = BBI[n * 16 + ci0 + e]; v[e] = im ? (pr * bi + pi * br) : (pr * br - pi * bi); }
                v4u o; o.x = pg8::cvt_pk_bf16(v[0], v[1]); o.y = pg8::cvt_pk_bf16(v[2], v[3]); o.z = pg8::cvt_pk_bf16(v[4], v[5]); o.w = pg8::cvt_pk_bf16(v[6], v[7]);
                *(v4u*)(MS + ((size_t)(gidx * 128 + rho)) * 256 + c8 * 8) = o; }
            __syncthreads();
        }
        for (int i = bx * NTHR + tid; i < 128 * 256 / 8; i += G * NTHR) *(v4u*)(MS + (size_t)4096 * 256 + (size_t)i * 8) = (v4u){0u, 0u, 0u, 0u};
        for (int i = bx * NTHR + tid; i < NIN; i += G * NTHR) BIASP[i] = args.in[3][bt1_src_col(i)] * (i >= 4608 ? NLOG2E : bt1_row_scale(i));
        for (int i = bx * NTHR + tid; i < D; i += G * NTHR) GINV[i] = 1.0f / args.in[1][i];
        __syncthreads();
        {
            LAS float* scr = (LAS float*)(lds + wave * 16384);
            constexpr int I1 = (D / 64) * (NIN / 32), I2A = (SSMW / 64) * (2048 / 32), I2B = (D / 64) * (D / 32), I3 = I2B, I4 = (D / 64) * (FF / 32), I5 = (FF / 64) * (D / 32);
#define P0_LOOP(base, cnt) for (int r = ((gw - (base)) % NGW + NGW) % NGW; r < (cnt); r += NGW)
            P0_LOOP(0, I1) { const int nblk = NIN / 32, kb = r / nblk, nb = r % nblk; p0_transpose_item<true>(args.in[2], D, NIN, BT1, nb * 32, 0, kb * 64, nullptr, scr, lane); }
            P0_LOOP(I1, I2A) { const int nblk = 2048 / 32, kb = r / nblk, nb = r % nblk, row0 = nb * 32, t = row0 >> 8, half = (row0 >> 7) & 1, j = row0 & 127;
                if (half) p0_transpose_item(args.in[13], SSMW, D, BT2A, row0, t * 128 + j, kb * 64, nullptr, scr, lane, NLOG2E);
                else p0_transpose_item(args.in[12], SSMW, D, BT2A, row0, t * 128 + j, kb * 64, nullptr, scr, lane, 1.0f / 255.0f); }
            P0_LOOP(I1 + I2A, I2B) { const int nblk = D / 32, kb = r / nblk, nb = r % nblk; p0_transpose_item(args.in[16], D, D, BT2B, nb * 32, nb * 32, kb * 64, nullptr, scr, lane, 1.0f / 255.0f); }
            P0_LOOP(I1 + I2A + I2B, I3) { const int nblk = D / 32, kb = r / nblk, nb = r % nblk; p0_transpose_item(args.in[17], D, D, BT3, nb * 32, nb * 32, kb * 64, nullptr, scr, lane); }
            P0_LOOP(I1 + I2A + I2B + I3, I4) { const int nblk = FF / 32, kb = r / nblk, nb = r % nblk; p0_transpose_item(args.in[19], D, FF, BT4, nb * 32, nb * 32, kb * 64, args.in[18], scr, lane); }
            P0_LOOP(I1 + I2A + I2B + I3 + I4, I5) { const int nblk = D / 32, kb = r / nblk, nb = r % nblk; p0_transpose_item(args.in[20], FF, D, BT5, nb * 32, nb * 32, kb * 64, nullptr, scr, lane); }
            P0_LOOP(I1 + I2A + I2B + I3 + I4 + I5, I2B) { const int nblk = D / 32, kb = r / nblk, nb = r % nblk; p0_transpose_item<false, true>(args.in[2], D, NIN, (bf16*)(ws + WS_BTGS8), nb * 32, 3584 + nb * 32, kb * 64, nullptr, scr, lane, NLOG2E); }
#undef P0_LOOP
        }
        {
            const f32x4* g4 = (const f32x4*)args.in[1] + 2 * lane; f32x4 gv[2][2];
#pragma unroll
            for (int j = 0; j < 2; ++j) { gv[j][0] = g4[128 * j]; gv[j][1] = g4[128 * j + 1]; }
            for (int m0 = gw * 4; m0 < M; m0 += NGW * 4) {
                f32x4 v[4][2][2]; float s[4];
#pragma unroll
                for (int r = 0; r < 4; ++r) { const f32x4* xr = (const f32x4*)(x + (size_t)(m0 + r) * D) + 2 * lane;
#pragma unroll
                    for (int j = 0; j < 2; ++j) { v[r][j][0] = xr[128 * j]; v[r][j][1] = xr[128 * j + 1]; } }
#pragma unroll
                for (int r = 0; r < 4; ++r) { f32x4 q = v[r][0][0] * v[r][0][0] + v[r][0][1] * v[r][0][1] + v[r][1][0] * v[r][1][0] + v[r][1][1] * v[r][1][1]; s[r] = (q[0] + q[1]) + (q[2] + q[3]); }
#pragma unroll
                for (int o = 1; o < 64; o <<= 1) {
#pragma unroll
                    for (int r = 0; r < 4; ++r) s[r] += __shfl_xor(s[r], o); }
#pragma unroll
                for (int r = 0; r < 4; ++r) { const float rms = sqrtf(s[r] * (1.0f / D) + EPS), ri = 1.0f / rms; if (lane == 0) RMS[m0 + r] = rms; u32x4* o16 = (u32x4*)(XN + (size_t)(m0 + r) * D) + lane; pg8::u32x2* o8 = (pg8::u32x2*)(ws + WS_XN8 + (size_t)(m0 + r) * D) + lane;
#pragma unroll
                    for (int j = 0; j < 2; ++j) { const f32x4 y0 = v[r][j][0] * ri * gv[j][0], y1 = v[r][j][1] * ri * gv[j][1]; o16[64 * j] = pg8::pack8(y0, y1);
                        pg8::u32x2 w8; w8.x = __builtin_amdgcn_cvt_pk_fp8_f32(y0[0], y0[1], 0u, false); w8.x = __builtin_amdgcn_cvt_pk_fp8_f32(y0[2], y0[3], w8.x, true);
                        w8.y = __builtin_amdgcn_cvt_pk_fp8_f32(y1[0], y1[1], 0u, false); w8.y = __builtin_amdgcn_cvt_pk_fp8_f32(y1[2], y1[3], w8.y, true); o8[64 * j] = w8; } }
            }
        }
    }
    SEAM(0);
    if (lo == 0 && hi == 8) { volatile LAS unsigned* st = (volatile LAS unsigned*)(lds + RING_BYTES);
        const unsigned uni = (unsigned)__builtin_amdgcn_readfirstlane((int)st[4]), xcc = (unsigned)__builtin_amdgcn_readfirstlane((int)st[2]), rk = (unsigned)__builtin_amdgcn_readfirstlane((int)st[3]);
        if (uni && xcc < 8u && rk < 32u) { local_ok = true; c = (int)(rk * 8u + xcc); } }
    const int cx = c & 7, cr = c >> 3;
    if (local_ok && XCC_STAGGER_TICKS) { const unsigned long long t0 = __builtin_amdgcn_s_memrealtime(); while (__builtin_amdgcn_s_memrealtime() - t0 < (unsigned long long)(cx * XCC_STAGGER_TICKS)) __builtin_amdgcn_s_sleep(8); }

    if (IN(1)) {
        pg8::Gemm g{ws, (unsigned)WS_XN, (unsigned)WS_BT1, D, D, D}; pg8::StaticOrder S; S.init(M, 4608, G, c);
        LAS float* PT = (LAS float*)(lds + RING_BYTES + 256);
        for (int i = tid; i < 3072; i += NTHR) { const int q = i / 192, T = (i / 64) % 3, ch = i & 63, wcc = ch >> 4, fqq = (ch >> 2) & 3, e = ch & 3;
            PT[i] = BIASP[(q + 2) * 256 + 128 * (T >> 1) + 32 * wcc + 8 * fqq + 4 * (T & 1) + e]; }
        for (int i = tid; i < 3 * D; i += NTHR) PT[3072 + i] = args.in[14][i];
        for (int i = tid; i < D; i += NTHR) PT[3072 + 3 * D + i] = args.in[15][i];
        __syncthreads();
        EpiG1 E{UA, CB, GS8, GC8, BIASP, args.in[14], args.in[15], HALO, CBH, PT};
        pg8::gemm_phase<EpiG1, pg8::StaticOrder>(lds, g, S, E);
        { pg8::Gemm g8{ws, (unsigned)WS_XN8, (unsigned)WS_BTGS8, 512, 512, 512}; pg8::StaticOrder S8; S8.init(M, D, G, c);
          EpiGS8 E8{GS8, BIASP + 4608}; pg8::gemm_phase<EpiGS8, pg8::StaticOrder>(lds, g8, S8, E8); }
    }
    SEAM(1);

    if (IN(2)) {
        { pg8::Gemm g{ws, (unsigned)WS_UA, (unsigned)WS_MS, UAK, 256, 256}; pg8::GroupOrder S{512, G, c, 128}; EpiS1 E{UA, ATAB};
          pg8::gemm_phase<EpiS1, pg8::GroupOrder>(lds, g, S, E); }
        asm volatile("s_waitcnt vmcnt(0)" ::: "memory"); __syncthreads();
        { pg8::Gemm g{ws, (unsigned)WS_UA, (unsigned)WS_TZ, UAK, UAK, UAK}; pg8::GroupOrder S{512, G, c, 256}; EpiS3 E{Z};
          pg8::gemm_phase<EpiS3, pg8::GroupOrder>(lds, g, S, E); }
        {
            const float* cw = args.in[14];
            const int it = cr * NTHR + tid, hb = 64 * cx + (it >> 8), c4 = (it & 255) * 4;
            if (((hb * 128) & (SEQ - 1)) != 0) {
                const f32x4 m2 = *(const f32x4*)(HALO + ((size_t)(hb - 1) * 2 + 0) * D + c4), m1 = *(const f32x4*)(HALO + ((size_t)(hb - 1) * 2 + 1) * D + c4);
                const f32x4 c0 = *(const f32x4*)(CBH + ((size_t)hb * 2 + 0) * D + c4), c1 = *(const f32x4*)(CBH + ((size_t)hb * 2 + 1) * D + c4);
                const f32x4 w0 = *(const f32x4*)(cw + c4), w1 = *(const f32x4*)(cw + D + c4);
                bf16* r0 = CB + (size_t)hb * 128 * D + c4; bf16* r1 = r0 + D;
                const pg8::u32x2 a0 = *(const pg8::u32x2*)r0, a1 = *(const pg8::u32x2*)r1;
                const f32x4 v0 = (f32x4){pg8::bf_lo(a0.x), pg8::bf_hi(a0.x), pg8::bf_lo(a0.y), pg8::bf_hi(a0.y)} + c0 * (w0 * m2 + w1 * m1);
                const f32x4 v1 = (f32x4){pg8::bf_lo(a1.x), pg8::bf_hi(a1.x), pg8::bf_lo(a1.y), pg8::bf_hi(a1.y)} + c1 * (w0 * m1);
                pg8::u32x2 o0, o1; o0.x = pg8::cvt_pk_bf16(v0[0], v0[1]); o0.y = pg8::cvt_pk_bf16(v0[2], v0[3]); o1.x = pg8::cvt_pk_bf16(v1[0], v1[1]); o1.y = pg8::cvt_pk_bf16(v1[2], v1[3]);
                *(pg8::u32x2*)r0 = o0; *(pg8::u32x2*)r1 = o1; }
        }
    }
    SEAM(2);

    if (IN(3)) {
        pg8::G2Order S; S.base.init(M, D, G, c);
        EpiG2ab E{EpiG2b{GC8, YB}, EpiG2a{GS8, YB, YB}};
        pg8::gemm_phase_multi<EpiG2ab, pg8::G2Order>(lds, ws, (unsigned)WS_CB, (unsigned)WS_BT2B, (unsigned)WS_Z, (unsigned)WS_BT2A, S, E);
    }
    SEAM(3);

    if (IN(4)) {
        pg8::Gemm g{ws, (unsigned)WS_YB, (unsigned)WS_BT3, D, D, D}; pg8::StaticOrder S; S.init(M, D, G, c);
        LAS float* RMSL = (LAS float*)(lds + RING_BYTES + 256);
        { Unit u; float rv[16]; bool ok[16];
#pragma unroll
          for (int i = 0; i < 16; ++i) { ok[i] = S.next(i, u); rv[i] = (ok[i] && tid < 256) ? RMS[(size_t)u.pm * BM + tid] : 0.f; }
#pragma unroll
          for (int i = 0; i < 16; ++i) if (ok[i] && tid < 256) RMSL[i * 256 + tid] = rv[i];
          __syncthreads(); }
        EpiRes6 E{XN, GINV, RMSL, SS2};
        pg8::gemm_phase<EpiRes6, pg8::StaticOrder>(lds, g, S, E);
    }
    SEAM(4);

    if (IN(5)) {
        pg8::Gemm g{ws, (unsigned)WS_HB, (unsigned)WS_BT4, D, D, D}; pg8::StaticOrder S; S.init(M, FF, G, c);
        LAS float* RI2 = (LAS float*)(lds + RING_BYTES + 256);
        { Unit u; const int r = tid >> 1, hf = tid & 1; f32x4 av[16], bv[16]; bool ok[16];
#pragma unroll
          for (int i = 0; i < 16; ++i) { ok[i] = S.next(i, u); const float* sp = SS2 + ((size_t)(ok[i] ? u.pm : 0) * BM + r) * 16 + hf * 8; av[i] = *(const f32x4*)sp; bv[i] = *(const f32x4*)(sp + 4); }
#pragma unroll
          for (int i = 0; i < 16; ++i) { const f32x4 a = av[i], b = bv[i];
              float sm = ((a[0] + a[1]) + (a[2] + a[3])) + ((b[0] + b[1]) + (b[2] + b[3])); sm += __shfl_xor(sm, 1);
              if (hf == 0 && ok[i]) RI2[i * 256 + r] = 1.0f / (sm * (1.0f / D) + EPS); }
          __syncthreads(); }
        EpiG4 E{HID, RI2};
        pg8::gemm_phase<EpiG4, pg8::StaticOrder>(lds, g, S, E);
    }
    SEAM(5);

    if (IN(6)) {
        pg8::Gemm g{ws, (unsigned)WS_HID, (unsigned)WS_BT5, FF, FF, FF}; pg8::StaticOrder S; S.init(M, D, G, c); EpiRes8 E{HB, SS3};
        pg8::gemm_phase<EpiRes8, pg8::StaticOrder>(lds, g, S, E);
    }
    SEAM(6);

    if (IN(7)) {
        const f32x4* g4 = (const f32x4*)args.in[21] + 2 * lane; f32x4 gv[2][2];
#pragma unroll
        for (int j = 0; j < 2; ++j) { gv[j][0] = g4[128 * j]; gv[j][1] = g4[128 * j + 1]; }
        for (int m = 8192 * cx + cr * NWAVES + wave; m < 8192 * (cx + 1); m += 32 * NWAVES) {
            float s = (lane < 16) ? SS3[(size_t)m * 16 + lane] : 0.f; s = wave_sum(s);
            const float ri = 1.0f / sqrtf(s * (1.0f / D) + EPS);
            const u32x4* hrow = (const u32x4*)(HB + (size_t)m * D) + lane; f32x4* orow = (f32x4*)(args.out + (size_t)m * D) + 2 * lane;
#pragma unroll
            for (int j = 0; j < 2; ++j) { f32x4 h0, h1; pg8::unpack8(hrow[64 * j], h0, h1); orow[128 * j] = h0 * ri * gv[j][0]; orow[128 * j + 1] = h1 * ri * gv[j][1]; }
        }
    }
#undef IN
#undef SEAM
}

extern "C" void kernel_launch(void* const* d_in, const int* in_sizes, int n_in, void* d_out, int out_size, void* d_ws, size_t ws_size, hipStream_t stream) {
    static int grid = 0;
    if (grid == 0) {
        if (n_in != 22 || in_sizes[0] != M * D || out_size != M * D || ws_size < WS_END) { fprintf(stderr, "kernel_launch: unexpected shapes: n_in %d in0 %d out %d ws %zu (need %zu)\n", n_in, n_in > 0 ? in_sizes[0] : -1, out_size, ws_size, (size_t)WS_END); grid = -1; return; }
        int dev = 0, cus = 0, per_cu = 0;
        if (hipGetDevice(&dev) != hipSuccess || hipDeviceGetAttribute(&cus, hipDeviceAttributeMultiprocessorCount, dev) != hipSuccess) { fprintf(stderr, "kernel_launch: device query failed\n"); grid = -1; return; }
        if (hipFuncSetAttribute((const void*)fwd_megakernel, hipFuncAttributeMaxDynamicSharedMemorySize, LDS_BYTES) != hipSuccess) { fprintf(stderr, "kernel_launch: hipFuncSetAttribute failed\n"); grid = -1; return; }
        if (hipOccupancyMaxActiveBlocksPerMultiprocessor(&per_cu, (const void*)fwd_megakernel, NTHR, LDS_BYTES) != hipSuccess || per_cu < 1) { fprintf(stderr, "kernel_launch: occupancy query says %d blocks per CU\n", per_cu); (void)hipGetLastError(); grid = -1; return; }
        if (cus != 256) { fprintf(stderr, "kernel_launch: built for a 256-CU device (unit dealing assumes 256 workgroups); found %d CUs\n", cus); grid = -1; return; }
        grid = cus;
    }
    if (grid < 0) return;
    if (hipMemsetAsync((char*)d_ws + WS_BAR, 0, 32768, stream) != hipSuccess) { fprintf(stderr, "kernel_launch: memset of the barrier words failed\n"); return; }
    Args a{};
    for (int i = 0; i < 22; ++i) a.in[i] = (const float*)d_in[i];
    a.out = (float*)d_out; a.ws = (unsigned char*)d_ws;
#if MK_PER_PHASE
    for (int p = 0; p < 8; ++p) { a.ph_lo = p; a.ph_hi = p + 1; void* kargs[] = {&a};
        hipError_t e = hipLaunchCooperativeKernel((const void*)fwd_megakernel, dim3(grid), dim3(NTHR), kargs, LDS_BYTES, stream);
        if (e != hipSuccess) { fprintf(stderr, "kernel_launch: phase %d launch failed: %s\n", p, hipGetErrorString(e)); break; } }
#else
    a.ph_lo = 0; a.ph_hi = 8; void* kargs[] = {&a};
    hipError_t e = hipLaunchCooperativeKernel((const void*)fwd_megakernel, dim3(grid), dim3(NTHR), kargs, LDS_BYTES, stream);
    if (e != hipSuccess) fprintf(stderr, "kernel_launch: cooperative launch failed: %s (grid %d)\n", hipGetErrorString(e), grid);
#endif
}
```
